# Optimizing an MI355X kernel written in HIP

```python
import jax, jax.numpy as jnp
from jax import lax
import numpy as np

D_MODEL = 1024
BATCH = 32
SEQ = 2048
DEPTH = 1
DEC_BATCH = 8
DEC_SEQ = 4096
PAST_LEN = 128

M_HEADS = 4
M_HEAD_DIM = 128
M_WIDTH = M_HEADS * M_HEAD_DIM
M_CHUNK = 64
N_GATE = 4 * M_HEADS
A_HEADS = 8
A_KV_HEADS = 2
A_GROUP = A_HEADS // A_KV_HEADS
A_HEAD_DIM = 64
A_WIDTH = A_HEADS * A_HEAD_DIM
A_KV_WIDTH = A_KV_HEADS * A_HEAD_DIM
WINDOW = 128
A_BLOCK = WINDOW
ROPE_THETA = 10000.0
D_FF = 2816
IN_COLS = 4 * M_WIDTH + N_GATE + A_WIDTH + 2 * A_KV_WIDTH + 2 * D_MODEL
EPS = 1e-6
NEG = -1e30

kernel_name = 'hybrid_mlstm_swa_encoder'


def rms_norm(x, g):
    xf = x.astype(jnp.float32)
    xf = xf * lax.rsqrt(jnp.mean(xf * xf, axis=-1, keepdims=True) + EPS)
    return xf.astype(x.dtype) * g


def swiglu(x, w1, w3, w2):
    return (jax.nn.silu(x @ w1) * (x @ w3)) @ w2


def rope(x, pos):
    half = x.shape[-1] // 2
    inv = jnp.power(ROPE_THETA, -jnp.arange(half, dtype=jnp.float32) / half)
    ang = pos.astype(jnp.float32)[:, None] * inv[None, :]
    cos = jnp.cos(ang)[:, None, :]
    sin = jnp.sin(ang)[:, None, :]
    xf = x.astype(jnp.float32)
    x1, x2 = xf[..., :half], xf[..., half:]
    return jnp.concatenate([x1 * cos - x2 * sin, x2 * cos + x1 * sin], axis=-1).astype(x.dtype)


def mlstm_dir(q, k, v, log_i, log_f):
    B, H, S, Dh = q.shape
    L = M_CHUNK
    NC = S // L
    qc = q.reshape(B, H, NC, L, Dh)
    kc = k.reshape(B, H, NC, L, Dh)
    vc = v.reshape(B, H, NC, L, Dh)
    li = log_i.reshape(B, H, NC, L)
    bcum = jnp.cumsum(log_f.reshape(B, H, NC, L), axis=-1)
    g = bcum[..., -1]
    a = g[..., None] - bcum + li
    m_loc = jnp.max(a, axis=-1)
    w = jnp.exp(a - m_loc[..., None])
    dC = jnp.einsum('bhcsk,bhcsv->bhckv', kc * w[..., None], vc)
    dn = jnp.einsum('bhcsk,bhcs->bhck', kc, w)

    def step(carry, inp):
        C, n, m = carry
        dC_c, dn_c, g_c, ml_c = inp
        m_new = jnp.maximum(g_c + m, ml_c)
        s_old = jnp.exp(g_c + m - m_new)
        s_new = jnp.exp(ml_c - m_new)
        C_new = s_old[..., None, None] * C + s_new[..., None, None] * dC_c
        n_new = s_old[..., None] * n + s_new[..., None] * dn_c
        return (C_new, n_new, m_new), (C, n, m)

    init = (jnp.zeros((B, H, Dh, Dh), jnp.float32),
            jnp.zeros((B, H, Dh), jnp.float32),
            jnp.full((B, H), NEG, jnp.float32))
    xs = (jnp.moveaxis(dC, 2, 0), jnp.moveaxis(dn, 2, 0),
          jnp.moveaxis(g, 2, 0), jnp.moveaxis(m_loc, 2, 0))
    _, (Cp, npv, mp) = lax.scan(step, init, xs)
    Cp = jnp.moveaxis(Cp, 0, 2)
    npv = jnp.moveaxis(npv, 0, 2)
    mp = jnp.moveaxis(mp, 0, 2)

    causal = jnp.tril(jnp.ones((L, L), dtype=bool))
    dmat = bcum[..., :, None] - bcum[..., None, :] + li[..., None, :]
    dmat = jnp.where(causal, dmat, NEG)
    m_inter = bcum + mp[..., None]
    m_t = jnp.maximum(jnp.max(dmat, axis=-1), m_inter)
    p = jnp.exp(dmat - m_t[..., None])
    wq = p * jnp.einsum('bhctd,bhcsd->bhcts', qc, kc)
    s_inter = jnp.exp(m_inter - m_t)
    num = (jnp.einsum('bhcts,bhcsv->bhctv', wq, vc)
           + s_inter[..., None] * jnp.einsum('bhctk,bhckv->bhctv', qc, Cp))
    den = jnp.sum(wq, axis=-1) + s_inter * jnp.einsum('bhctk,bhck->bhct', qc, npv)
    h = num / jnp.maximum(jnp.abs(den), jnp.exp(-m_t))[..., None]
    return h.reshape(B, H, S, Dh)


def mlstm_branch(mq, mk, mv, mo, mg, b_gates, m_norm):
    B, S, _ = mq.shape

    def heads(t):
        return t.reshape(B, S, M_HEADS, M_HEAD_DIM).transpose(0, 2, 1, 3).astype(jnp.float32)

    qh = heads(mq)
    kh = heads(mk) * (M_HEAD_DIM ** -0.5)
    vh = heads(mv)
    gt = (mg + b_gates).astype(jnp.float32).reshape(B, S, 4, M_HEADS).transpose(2, 0, 3, 1)
    i_f, f_f, i_b, f_b = gt[0], gt[1], gt[2], gt[3]
    h_fwd = mlstm_dir(qh, kh, vh, i_f, jax.nn.log_sigmoid(f_f))
    flip = lambda t: jnp.flip(t, axis=2)
    h_bwd = flip(mlstm_dir(flip(qh), flip(kh), flip(vh), flip(i_b), flip(jax.nn.log_sigmoid(f_b))))
    h = h_fwd + h_bwd
    h = h * lax.rsqrt(jnp.mean(h * h, axis=-1, keepdims=True) + EPS)
    h = h.transpose(0, 2, 1, 3).reshape(B, S, M_WIDTH).astype(mq.dtype) * m_norm
    return h * jax.nn.sigmoid(mo)


def window_attn_branch(aq, ak, av, q_norm, k_norm, sink):
    B, S, _ = aq.shape
    NB = S // A_BLOCK
    q = rms_norm(aq.reshape(B, S, A_HEADS, A_HEAD_DIM), q_norm)
    k = rms_norm(ak.reshape(B, S, A_KV_HEADS, A_HEAD_DIM), k_norm)
    v = av.reshape(B, S, A_KV_HEADS, A_HEAD_DIM)
    pos = jnp.arange(S)
    q = rope(q, pos)
    k = rope(k, pos)

    def band(t):
        tp = jnp.pad(t, ((0, 0), (WINDOW, WINDOW), (0, 0), (0, 0)))
        tp = tp.reshape(B, NB + 2, A_BLOCK, A_KV_HEADS, A_HEAD_DIM)
        return jnp.concatenate([tp[:, :-2], tp[:, 1:-1], tp[:, 2:]], axis=2)

    kw = band(k)
    vw = band(v)
    qb = q.reshape(B, NB, A_BLOCK, A_KV_HEADS, A_GROUP, A_HEAD_DIM)
    s = jnp.einsum('bnqhgd,bnkhd->bnhgqk', qb, kw).astype(jnp.float32) * (A_HEAD_DIM ** -0.5)
    qi = jnp.arange(A_BLOCK)
    kj = jnp.arange(3 * A_BLOCK)
    rel = kj[None, :] - WINDOW - qi[:, None]
    kpos = jnp.arange(NB)[:, None] * A_BLOCK - WINDOW + kj[None, :]
    mask = (jnp.abs(rel) <= WINDOW)[None, :, :] & ((kpos >= 0) & (kpos < S))[:, None, :]
    s = jnp.where(mask[None, :, None, None, :, :], s, NEG)
    sk = sink.astype(jnp.float32).reshape(A_KV_HEADS, A_GROUP)[None, None, :, :, None, None]
    m = jnp.maximum(jnp.max(s, axis=-1, keepdims=True), sk)
    p = jnp.exp(s - m)
    den = jnp.sum(p, axis=-1, keepdims=True) + jnp.exp(sk - m)
    o = jnp.einsum('bnhgqk,bnkhd->bnqhgd', (p / den).astype(v.dtype), vw)
    return o.reshape(B, S, A_WIDTH)


def encoder_layer(x, ffn1_norm, ffn1_w1, ffn1_w3, ffn1_w2, mix_norm, w_in, b_gates, m_norm,
                  q_norm, k_norm, sink, w_pm, w_pa, w_out, ffn2_norm, ffn2_w1, ffn2_w3, ffn2_w2):
    x = x + 0.5 * swiglu(rms_norm(x, ffn1_norm), ffn1_w1, ffn1_w3, ffn1_w2)
    h = rms_norm(x, mix_norm)
    z = h @ w_in
    sizes = (M_WIDTH, M_WIDTH, M_WIDTH, M_WIDTH, N_GATE, A_WIDTH, A_KV_WIDTH, A_KV_WIDTH, D_MODEL, D_MODEL)
    idx = [sum(sizes[:i + 1]) for i in range(len(sizes) - 1)]
    mq, mk, mv, mo, mg, aq, ak, av, gm, ga = jnp.split(z, idx, axis=-1)
    hm = mlstm_branch(mq, mk, mv, mo, mg, b_gates, m_norm)
    ha = window_attn_branch(aq, ak, av, q_norm, k_norm, sink)
    merged = jax.nn.sigmoid(gm) * (hm @ w_pm) + jax.nn.sigmoid(ga) * (ha @ w_pa)
    x = x + merged @ w_out
    x = x + 0.5 * swiglu(rms_norm(x, ffn2_norm), ffn2_w1, ffn2_w3, ffn2_w2)
    return x


def setup_inputs(seed: int = 0) -> dict:
    key = jax.random.key(seed)
    ks = jax.random.split(key, 24)
    f32 = jnp.float32

    def nrm(k, shape, fan_in):
        return jax.random.normal(k, shape, f32) * (fan_in ** -0.5)

    def gain(k, shape):
        return 1.0 + 0.05 * jax.random.normal(k, shape, f32)

    gate_base = jnp.tile(jnp.concatenate([jnp.zeros((M_HEADS,), f32),
                                          jnp.linspace(3.0, 6.0, M_HEADS, dtype=f32)]), 2)
    return {
        'x_prompt': jax.random.normal(ks[0], (BATCH, SEQ, D_MODEL), f32),
        'x_sample': jax.random.normal(ks[1], (DEC_BATCH, DEC_SEQ, D_MODEL), f32),
        'ffn1_norm': gain(ks[2], (DEPTH, D_MODEL)),
        'ffn1_w1': nrm(ks[3], (DEPTH, D_MODEL, D_FF), D_MODEL),
        'ffn1_w3': nrm(ks[4], (DEPTH, D_MODEL, D_FF), D_MODEL),
        'ffn1_w2': nrm(ks[5], (DEPTH, D_FF, D_MODEL), D_FF),
        'mix_norm': gain(ks[6], (DEPTH, D_MODEL)),
        'w_in': nrm(ks[7], (DEPTH, D_MODEL, IN_COLS), D_MODEL),
        'b_gates': gate_base[None, :] + 0.1 * jax.random.normal(ks[8], (DEPTH, N_GATE), f32),
        'm_norm': gain(ks[9], (DEPTH, M_WIDTH)),
        'q_norm': gain(ks[10], (DEPTH, A_HEAD_DIM)),
        'k_norm': gain(ks[11], (DEPTH, A_HEAD_DIM)),
        'sink': 0.5 * jax.random.normal(ks[12], (DEPTH, A_HEADS), f32),
        'w_pm': nrm(ks[13], (DEPTH, M_WIDTH, D_MODEL), M_WIDTH),
        'w_pa': nrm(ks[14], (DEPTH, A_WIDTH, D_MODEL), A_WIDTH),
        'w_out': nrm(ks[15], (DEPTH, D_MODEL, D_MODEL), D_MODEL),
        'ffn2_norm': gain(ks[16], (DEPTH, D_MODEL)),
        'ffn2_w1': nrm(ks[17], (DEPTH, D_MODEL, D_FF), D_MODEL),
        'ffn2_w3': nrm(ks[18], (DEPTH, D_MODEL, D_FF), D_MODEL),
        'ffn2_w2': nrm(ks[19], (DEPTH, D_FF, D_MODEL), D_FF),
    }


def reference(x_prompt, x_sample, ffn1_norm, ffn1_w1, ffn1_w3, ffn1_w2, mix_norm, w_in, b_gates,
              m_norm, q_norm, k_norm, sink, w_pm, w_pa, w_out, ffn2_norm, ffn2_w1, ffn2_w3, ffn2_w2):
    y_prompt = x_prompt
    y_sample = x_sample
    for l in range(DEPTH):
        y_prompt = encoder_layer(y_prompt, ffn1_norm[l], ffn1_w1[l], ffn1_w3[l], ffn1_w2[l], mix_norm[l],
                                 w_in[l], b_gates[l], m_norm[l], q_norm[l], k_norm[l], sink[l], w_pm[l],
                                 w_pa[l], w_out[l], ffn2_norm[l], ffn2_w1[l], ffn2_w3[l], ffn2_w2[l])
        y_sample = encoder_layer(y_sample, ffn1_norm[l], ffn1_w1[l], ffn1_w3[l], ffn1_w2[l], mix_norm[l],
                                 w_in[l], b_gates[l], m_norm[l], q_norm[l], k_norm[l], sink[l], w_pm[l],
                                 w_pa[l], w_out[l], ffn2_norm[l], ffn2_w1[l], ffn2_w3[l], ffn2_w2[l])
    return (y_prompt, y_sample)
```

```cpp
#include <hip/hip_runtime.h>
#include <hip/hip_cooperative_groups.h>
#include <cstdio>
#include <cstdint>
namespace cg = cooperative_groups;

#ifndef MK_MULTI_LAUNCH
#define MK_MULTI_LAUNCH 0
#endif

#define LAS __attribute__((address_space(3)))
typedef unsigned short bf16_t;
typedef short bf16x8 __attribute__((ext_vector_type(8)));
typedef float f32x4 __attribute__((ext_vector_type(4)));
typedef unsigned u32x4 __attribute__((ext_vector_type(4)));
typedef unsigned u32x2 __attribute__((ext_vector_type(2)));

constexpr int D = 1024, T_P = 32 * 2048, T_S = 8 * 4096, T = T_P + T_S;
constexpr int FF = 2816, ZC = 2816, GC = 2048, INC = 4880;
constexpr int NPH = 10;
constexpr float EPS = 1e-6f;
constexpr int NTHREADS = 512;
constexpr int LDS_BYTES = 163840;

constexpr size_t al256(size_t x) { return (x + 255) & ~(size_t)255; }
constexpr size_t WS_W13A = 0;
constexpr size_t WS_W2A  = WS_W13A + al256((size_t)2 * FF * D * 2);
constexpr size_t WS_WIN  = WS_W2A + al256((size_t)D * FF * 2);
constexpr size_t WS_WG   = WS_WIN + al256((size_t)4864 * D * 2);
constexpr size_t WS_WPM  = WS_WG + al256((size_t)16 * D * 2);
constexpr size_t WS_WPA  = WS_WPM + al256((size_t)D * 512 * 2);
constexpr size_t WS_WOUT = WS_WPA + al256((size_t)D * 512 * 2);
constexpr size_t WS_W13B = WS_WOUT + al256((size_t)D * D * 2);
constexpr size_t WS_W2B  = WS_W13B + al256((size_t)2 * FF * D * 2);
constexpr size_t WS_ROPE = WS_W2B + al256((size_t)D * FF * 2);
constexpr size_t WS_GATES = WS_ROPE + al256((size_t)4096 * 32 * 8);
constexpr size_t WS_PS0  = WS_GATES + al256((size_t)T * 16 * 4);
constexpr size_t WS_PS1  = WS_PS0 + al256((size_t)T * 4);
constexpr size_t WS_PS2  = WS_PS1 + al256((size_t)T * 4);
constexpr size_t WS_XB   = WS_PS2 + al256((size_t)T * 4);
constexpr size_t WS_R1   = WS_XB + al256((size_t)T * D * 2);
constexpr size_t WS_HFB  = WS_R1 + al256((size_t)T * ZC * 2);
constexpr size_t WS_CTR  = WS_HFB + al256((size_t)T * D * 2);
constexpr size_t WS_BAR  = WS_CTR + 256;
constexpr size_t WS_END  = WS_BAR + 16384;

__device__ __forceinline__ unsigned cvt_pk_bf16(float lo, float hi) { unsigned r; asm("v_cvt_pk_bf16_f32 %0, %1, %2" : "=v"(r) : "v"(lo), "v"(hi)); return r; }
__device__ __forceinline__ unsigned pk2(float lo, float hi) { return cvt_pk_bf16(lo, hi); }
__device__ __forceinline__ unsigned f2bf(float f) { return cvt_pk_bf16(f, 0.f) & 0xffffu; }
__device__ __forceinline__ unsigned f2bf_sw(float f) { unsigned u = __float_as_uint(f); return (u + 0x7fffu + ((u >> 16) & 1u)) >> 16; }
__device__ __forceinline__ unsigned pk2_sw(float lo, float hi) { return f2bf_sw(lo) | (f2bf_sw(hi) << 16); }
__device__ __forceinline__ float bf_lo(unsigned u) { return __uint_as_float(u << 16); }
__device__ __forceinline__ float bf_hi(unsigned u) { return __uint_as_float(u & 0xffff0000u); }
__device__ __forceinline__ float rcpf_(float x) { return __builtin_amdgcn_rcpf(x); }
__device__ __forceinline__ float sigmoidf_(float x) { return rcpf_(1.f + __expf(-x)); }
__device__ __forceinline__ f32x4 mfma16(bf16x8 a, bf16x8 b, f32x4 c) { return __builtin_amdgcn_mfma_f32_16x16x32_bf16(a, b, c, 0, 0, 0); }
#define LDS_WAIT() asm volatile("s_waitcnt lgkmcnt(0)" ::: "memory")

namespace pg8 {
constexpr int BM = 256, BK = 64, HALF = 128, HTB = HALF * BK * 2, STAGE_BYTES = 8 * HTB, NXCD = 8, WGM = 8;
__device__ __forceinline__ int lds_byte(int r, int c) { const int st = (r >> 4) * 2 + (c >> 5), rr = r & 15, cc = c & 31, ob = rr * 64 + cc * 2; return st * 1024 + (ob ^ (((ob >> 9) & 1) << 5)); }
__device__ __forceinline__ void stage_rc(int b, int& R, int& C) { const int st = b / 1024, sb = b % 1024, swz = sb ^ (((sb >> 9) & 1) << 5); R = (st >> 1) * 16 + swz / 64; C = (st & 1) * 32 + (swz % 64) / 2; }
__device__ __forceinline__ int perm32(int rho) { const int n = rho >> 4, i = rho & 15; return 8 * (i >> 2) + 4 * n + (i & 3); }

struct Unit { const char* A; const char* B; int pm, pn, sub; };

__device__ __forceinline__ void tile_of(int L, int nM, int nN, int& pm, int& pn) {
    const int nwg = nM * nN; int wgid = L;
    { const int q = nwg / NXCD, r = nwg % NXCD, xcd = wgid % NXCD, off = wgid / NXCD; wgid = (xcd < r ? xcd * (q + 1) : r * (q + 1) + (xcd - r) * q) + off; }
    const int nig = WGM * nN, gid = wgid / nig, fm = gid * WGM, gsz = (nM - fm) < WGM ? (nM - fm) : WGM;
    pm = fm + ((wgid % nig) % gsz); pn = (wgid % nig) / gsz;
}
struct SchedPlain {
    const char* A; const char* B; int lda, ldb, nM, nN, G, c;
    __device__ __forceinline__ bool next(int i, Unit& u) const {
        const long L = (long)i * G + c; if (L >= (long)nM * nN) return false;
        tile_of((int)L, nM, nN, u.pm, u.pn); u.sub = 0;
        u.A = A + (size_t)u.pm * BM * lda * 2; u.B = B + (size_t)u.pn * BM * ldb * 2; return true;
    }
};
struct SchedPair {
    const char* A0; const char* A1; const char* B0; const char* B1; int lda, ldb, nM, nN, G, c;
    __device__ __forceinline__ bool next(int i, Unit& u) const {
        const long L = (long)(i >> 1) * G + c; if (L >= (long)nM * nN) return false;
        tile_of((int)L, nM, nN, u.pm, u.pn); u.sub = i & 1;
        u.A = (u.sub ? A1 : A0) + (size_t)u.pm * BM * lda * 2; u.B = (u.sub ? B1 : B0) + (size_t)u.pn * BM * ldb * 2; return true;
    }
};

template <class Epi, class Sched>
__device__ __forceinline__ void gemm_phase(LAS unsigned char* lds, const int lda, const int ldb, const int K, const Sched& S, const Epi& E) {
    const int tid = threadIdx.x, wid = __builtin_amdgcn_readfirstlane(tid >> 6), lane = tid & 63, wr = wid >> 2, wc = wid & 3, fr = lane & 15, fq = lane >> 4;
    const int nt = K / BK;
    unsigned voffA[2], voffB[2];
#pragma unroll
    for (int i = 0; i < 2; ++i) { int R, C; stage_rc(tid * 16 + i * 8192, R, C); const int Rb = (R & ~31) + perm32(R & 31);
        voffA[i] = (unsigned)(R * lda + C) * 2u; voffB[i] = (unsigned)(Rb * ldb + C) * 2u; }
    const size_t kstep = (size_t)(BK * 2);
    const size_t hstepA = (size_t)HALF * lda * 2, hstepB = (size_t)HALF * ldb * 2;
    const unsigned ldsw = (unsigned)wid * 1024u;
    const int aoff = lds_byte(wr * 64 + fr, fq * 8), boff = lds_byte(wc * 32 + fr, fq * 8);
#define PG8_SA(b, h) (((b) * 2 + (h)) * HTB)
#define PG8_SB(b, h) ((4 + (b) * 2 + (h)) * HTB)
#define PG8_STAGE(bufoff, gbase, voff) do { _Pragma("unroll") for (int _i = 0; _i < 2; ++_i) \
        __builtin_amdgcn_global_load_lds((const unsigned*)((const char*)(gbase) + (voff)[_i]), (LAS unsigned*)(lds + (bufoff) + ldsw + _i * 8192), 16, 0, 0); } while (0)
#define PG8_LDA(dst, b, h) do { _Pragma("unroll") for (int m = 0; m < 4; ++m) _Pragma("unroll") for (int k = 0; k < 2; ++k) dst[m][k] = *(const LAS bf16x8*)(lds + PG8_SA(b, h) + aoff + m * 2048 + k * 1024); } while (0)
#define PG8_LDB(dst, b, h) do { _Pragma("unroll") for (int n = 0; n < 2; ++n) _Pragma("unroll") for (int k = 0; k < 2; ++k) dst[n][k] = *(const LAS bf16x8*)(lds + PG8_SB(b, h) + boff + n * 2048 + k * 1024); } while (0)
#define PG8_MMA(ai, bj, At, Bt) do { __builtin_amdgcn_s_setprio(1); _Pragma("unroll") for (int m = 0; m < 4; ++m) _Pragma("unroll") for (int n = 0; n < 2; ++n) _Pragma("unroll") for (int k = 0; k < 2; ++k) \
        acc[ai][bj][m][n] = __builtin_amdgcn_mfma_f32_16x16x32_bf16(Bt[n][k], At[m][k], acc[ai][bj][m][n], 0, 0, 0); __builtin_amdgcn_s_setprio(0); } while (0)
#define PG8_WAIT_V(n) asm volatile("s_waitcnt vmcnt(" #n ")" ::: "memory")
#define PG8_WAIT_L(n) asm volatile("s_waitcnt lgkmcnt(" #n ")" ::: "memory")
#define PG8_BAR __builtin_amdgcn_s_barrier()
#define PG8_SCHED __builtin_amdgcn_sched_barrier(0)
    Unit cur, nxt; int ui = 0;
    if (!S.next(0, cur)) return;
    f32x4 acc[2][2][4][2];
#pragma unroll
    for (int a = 0; a < 2; ++a)
#pragma unroll
        for (int b = 0; b < 2; ++b)
#pragma unroll
            for (int m = 0; m < 4; ++m)
#pragma unroll
                for (int n = 0; n < 2; ++n) acc[a][b][m][n] = (f32x4){0.f, 0.f, 0.f, 0.f};
    bf16x8 At[4][2], B0[2][2], B1[2][2];
    float rsv[8];
#pragma unroll
    for (int i = 0; i < 8; ++i) rsv[i] = 0.f;
    const char* cA = cur.A; const char* cB = cur.B;
    PG8_STAGE(PG8_SB(0, 0), cB, voffB); PG8_STAGE(PG8_SB(0, 1), cB + hstepB, voffB); PG8_STAGE(PG8_SA(0, 0), cA, voffA); PG8_STAGE(PG8_SA(0, 1), cA + hstepA, voffA);
    if (wr == 1) PG8_BAR;
    PG8_WAIT_V(2); PG8_BAR;
    PG8_STAGE(PG8_SB(1, 0), cB + kstep, voffB); PG8_STAGE(PG8_SA(1, 0), cA + kstep, voffA); PG8_STAGE(PG8_SB(1, 1), cB + hstepB + kstep, voffB);
    PG8_WAIT_V(6); PG8_BAR;
    for (;;) {
        const bool has_next = S.next(ui + 1, nxt);
        const char* nA = has_next ? nxt.A : cA; const char* nB = has_next ? nxt.B : cB;
        for (int t = 0; t < nt; t += 2) {
            const bool last = (t == nt - 2);
            const char* a1 = cA + (size_t)(t + 1) * kstep;
            const char* a2 = last ? nA : cA + (size_t)(t + 2) * kstep; const char* b2 = last ? nB : cB + (size_t)(t + 2) * kstep;
            const char* a3 = a2 + kstep; const char* b3 = b2 + kstep;
            PG8_LDB(B0, 0, 0); PG8_LDB(B1, 0, 1); PG8_SCHED; PG8_LDA(At, 0, 0); PG8_STAGE(PG8_SA(1, 1), a1 + hstepA, voffA);
            PG8_WAIT_V(8); PG8_WAIT_L(0); PG8_BAR; PG8_MMA(0, 0, At, B0); PG8_MMA(0, 1, At, B1); PG8_BAR; PG8_SCHED;
            PG8_LDA(At, 0, 1); PG8_STAGE(PG8_SB(0, 0), b2, voffB); PG8_STAGE(PG8_SB(0, 1), b2 + hstepB, voffB); PG8_STAGE(PG8_SA(0, 0), a2, voffA);
            PG8_WAIT_V(8); PG8_WAIT_L(0); PG8_BAR; PG8_MMA(1, 0, At, B0); PG8_MMA(1, 1, At, B1); PG8_BAR; PG8_SCHED;
            PG8_LDB(B0, 1, 0); PG8_LDB(B1, 1, 1); PG8_SCHED; PG8_LDA(At, 1, 0); PG8_STAGE(PG8_SA(0, 1), a2 + hstepA, voffA);
            PG8_WAIT_V(8); PG8_WAIT_L(0); PG8_BAR; PG8_MMA(0, 0, At, B0); PG8_MMA(0, 1, At, B1); PG8_BAR; PG8_SCHED;
            PG8_LDA(At, 1, 1); PG8_STAGE(PG8_SB(1, 0), b3, voffB); PG8_STAGE(PG8_SB(1, 1), b3 + hstepB, voffB); PG8_STAGE(PG8_SA(1, 0), a3, voffA);
            PG8_WAIT_V(8); PG8_WAIT_L(0); PG8_BAR;
            if (last) E.pre(cur, wr, fr, rsv);
            PG8_MMA(1, 0, At, B0); PG8_MMA(1, 1, At, B1); PG8_BAR; PG8_SCHED;
        }
        if (wr == 0) PG8_BAR;
        const bool keep = E(acc, cur, wr, wc, fr, fq, rsv);
        if (!has_next) break;
        if (!keep) {
#pragma unroll
            for (int a = 0; a < 2; ++a)
#pragma unroll
                for (int b = 0; b < 2; ++b)
#pragma unroll
                    for (int m = 0; m < 4; ++m)
#pragma unroll
                        for (int n = 0; n < 2; ++n) acc[a][b][m][n] = (f32x4){0.f, 0.f, 0.f, 0.f};
        }
        cur = nxt; cA = nA; cB = nB; ++ui;
        if (wr == 1) PG8_BAR;
    }
    PG8_WAIT_V(0);
    PG8_BAR;
#undef PG8_SA
#undef PG8_SB
#undef PG8_STAGE
#undef PG8_LDA
#undef PG8_LDB
#undef PG8_MMA
#undef PG8_WAIT_V
#undef PG8_WAIT_L
#undef PG8_BAR
#undef PG8_SCHED
}
}

typedef f32x4 AccT[2][2][4][2];

__device__ __forceinline__ float row_rs(const float* ss, int row) { return rsqrtf(ss[row] * (1.f / 1024.f) + EPS); }
__device__ __forceinline__ float silu_mul(float a, float b) { return a * rcpf_(1.f + __expf(-a)) * b; }

struct EpiSwiglu {
    const float* ss; bf16_t* H;
    __device__ __forceinline__ void pre(const pg8::Unit& u, int wr, int fr, float (&rsv)[8]) const {
        const float* p = ss + u.pm * 256 + wr * 64 + fr;
#pragma unroll
        for (int ai = 0; ai < 2; ++ai)
#pragma unroll
            for (int m = 0; m < 4; ++m) rsv[ai * 4 + m] = p[ai * 128 + m * 16];
    }
    __device__ __forceinline__ bool operator()(AccT& acc, const pg8::Unit& u, int wr, int wc, int fr, int fq, const float (&rsv)[8]) const {
        const int row0 = u.pm * 256 + wr * 64 + fr, col0 = u.pn * 128 + wc * 32 + 8 * fq;
#pragma unroll
        for (int ai = 0; ai < 2; ++ai)
#pragma unroll
            for (int m = 0; m < 4; ++m) {
                const int row = row0 + ai * 128 + m * 16; const float r = rsqrtf(rsv[ai * 4 + m] * (1.f / 1024.f) + EPS);
                typedef float f32x2 __attribute__((ext_vector_type(2)));
                const float rn = r * -1.4426950408889634f, r2 = r * r;
                u32x4 w;
#pragma unroll
                for (int n = 0; n < 2; ++n) {
                    const f32x4 gv = acc[ai][0][m][n], uv = acc[ai][1][m][n];
#pragma unroll
                    for (int p = 0; p < 2; ++p) {
                        const f32x2 g2 = {gv[2 * p], gv[2 * p + 1]}, u2 = {uv[2 * p], uv[2 * p + 1]};
                        const f32x2 x2 = g2 * rn; f32x2 e2; e2.x = __builtin_amdgcn_exp2f(x2.x); e2.y = __builtin_amdgcn_exp2f(x2.y);
                        const f32x2 d2 = e2 + 1.0f; f32x2 c2; c2.x = rcpf_(d2.x); c2.y = rcpf_(d2.y);
                        const f32x2 h2 = (g2 * u2) * (c2 * r2);
                        w[2 * n + p] = cvt_pk_bf16(h2.x, h2.y); } }
                *(u32x4*)(H + (size_t)row * FF + col0) = w;
            }
        return false;
    }
};
template <int MODE> struct EpiRes {
    const float* xp; const float* xs; float* out; bf16_t* xb; float* ss;
    __device__ __forceinline__ void pre(const pg8::Unit&, int, int, float (&)[8]) const {}
    __device__ __forceinline__ bool operator()(AccT& acc, const pg8::Unit& u, int wr, int wc, int fr, int fq, const float (&)[8]) const {
        const int row0 = u.pm * 256 + wr * 64 + fr, colt = u.pn * 256 + wc * 32 + 8 * fq;
#pragma unroll
        for (int ai = 0; ai < 2; ++ai) {
            f32x4 xv[4][2][2];
#pragma unroll
            for (int m = 0; m < 4; ++m)
#pragma unroll
                for (int bj = 0; bj < 2; ++bj) {
                    const int row = row0 + ai * 128 + m * 16, col = colt + bj * 128;
                    {   const u32x4 xw = __builtin_nontemporal_load((const u32x4*)(xb + (size_t)row * D + col));
                        xv[m][bj][0] = (f32x4){bf_lo(xw.x), bf_hi(xw.x), bf_lo(xw.y), bf_hi(xw.y)}; xv[m][bj][1] = (f32x4){bf_lo(xw.z), bf_hi(xw.z), bf_lo(xw.w), bf_hi(xw.w)}; }
                }
#pragma unroll
            for (int m = 0; m < 4; ++m) {
                const int row = row0 + ai * 128 + m * 16; float sq = 0.f;
#pragma unroll
                for (int bj = 0; bj < 2; ++bj) {
                    const int col = colt + bj * 128; const float sc = (MODE == 1) ? 1.f : 0.5f;
                    const f32x4 v0 = xv[m][bj][0] + sc * acc[ai][bj][m][0], v1 = xv[m][bj][1] + sc * acc[ai][bj][m][1];
                    if (MODE == 2) { float* o = out + (size_t)row * D + col; __builtin_nontemporal_store(v0, (f32x4*)o); __builtin_nontemporal_store(v1, (f32x4*)(o + 4)); }
                    if (MODE != 2) {
                        sq += (v0[0] * v0[0] + v0[1] * v0[1]) + (v0[2] * v0[2] + v0[3] * v0[3]) + (v1[0] * v1[0] + v1[1] * v1[1]) + (v1[2] * v1[2] + v1[3] * v1[3]);
                        u32x4 w; w.x = cvt_pk_bf16(v0[0], v0[1]); w.y = cvt_pk_bf16(v0[2], v0[3]); w.z = cvt_pk_bf16(v1[0], v1[1]); w.w = cvt_pk_bf16(v1[2], v1[3]);
                        *(u32x4*)(xb + (size_t)row * D + col) = w; }
                }
                if (MODE != 2) { sq += __shfl_xor(sq, 16); sq += __shfl_xor(sq, 32); if (fq == 0) unsafeAtomicAdd(ss + row, sq); }
            }
        }
        return false;
    }
};
struct EpiIn {
    const float* ss; bf16_t* Z; bf16_t* ZG;
    __device__ __forceinline__ void pre(const pg8::Unit& u, int wr, int fr, float (&rsv)[8]) const {
        const float* p = ss + u.pm * 256 + wr * 64 + fr;
#pragma unroll
        for (int ai = 0; ai < 2; ++ai)
#pragma unroll
            for (int m = 0; m < 4; ++m) rsv[ai * 4 + m] = p[ai * 128 + m * 16];
    }
    __device__ __forceinline__ bool operator()(AccT& acc, const pg8::Unit& u, int wr, int wc, int fr, int fq, const float (&rsv)[8]) const {
        const int row0 = u.pm * 256 + wr * 64 + fr; const bool gate = u.pn >= 11;
        if (!gate) {
            bf16_t* base = Z + u.pn * 256 + wc * 32 + 8 * fq;
#pragma unroll
            for (int ai = 0; ai < 2; ++ai)
#pragma unroll
                for (int m = 0; m < 4; ++m) {
                    const int row = row0 + ai * 128 + m * 16; const float r = rsqrtf(rsv[ai * 4 + m] * (1.f / 1024.f) + EPS);
#pragma unroll
                    for (int bj = 0; bj < 2; ++bj) {
                        const f32x4 v0 = acc[ai][bj][m][0] * r, v1 = acc[ai][bj][m][1] * r;
                        u32x4 w; w.x = cvt_pk_bf16(v0[0], v0[1]); w.y = cvt_pk_bf16(v0[2], v0[3]); w.z = cvt_pk_bf16(v1[0], v1[1]); w.w = cvt_pk_bf16(v1[2], v1[3]);
                        *(u32x4*)(base + (size_t)row * ZC + bj * 128) = w;
                    }
                }
        } else {
            bf16_t* base = ZG + (u.pn - 11) * 128 + wc * 32 + 8 * fq;
#pragma unroll
            for (int ai = 0; ai < 2; ++ai)
#pragma unroll
                for (int m = 0; m < 4; ++m) {
                    const int row = row0 + ai * 128 + m * 16; const float rn = rsqrtf(rsv[ai * 4 + m] * (1.f / 1024.f) + EPS) * -1.4426950408889634f;
                    float rho[8], sga[8];
#pragma unroll
                    for (int n = 0; n < 2; ++n)
#pragma unroll
                        for (int j = 0; j < 4; ++j) {
                            const float em = __builtin_amdgcn_exp2f(fminf(acc[ai][0][m][n][j] * rn, 60.f)), ea = __builtin_amdgcn_exp2f(fminf(acc[ai][1][m][n][j] * rn, 60.f));
                            sga[4 * n + j] = rcpf_(1.f + ea); rho[4 * n + j] = (1.f + ea) * rcpf_(1.f + em); }
                    u32x4 w0, w1;
#pragma unroll
                    for (int k = 0; k < 4; ++k) { w0[k] = cvt_pk_bf16(rho[2 * k], rho[2 * k + 1]); w1[k] = cvt_pk_bf16(sga[2 * k], sga[2 * k + 1]); }
                    *(u32x4*)(base + (size_t)row * GC) = w0; *(u32x4*)(base + (size_t)row * GC + 1024) = w1;
                }
        }
        return false;
    }
};
struct EpiMerge {
    const bf16_t* ZG; bf16_t* MRG;
    __device__ __forceinline__ void pre(const pg8::Unit&, int, int, float (&)[8]) const {}
    __device__ __forceinline__ bool operator()(AccT& acc, const pg8::Unit& u, int wr, int wc, int fr, int fq, const float (&)[8]) const {
        const int row0 = u.pm * 256 + wr * 64 + fr, colt = u.pn * 256 + wc * 32 + 8 * fq;
        const bf16_t* gsrc = ZG + (u.sub ? 1024 : 0) + colt;
#pragma unroll
        for (int ai = 0; ai < 2; ++ai) {
            u32x4 gv[4][2];
#pragma unroll
            for (int m = 0; m < 4; ++m)
#pragma unroll
                for (int bj = 0; bj < 2; ++bj) gv[m][bj] = __builtin_nontemporal_load((const u32x4*)(gsrc + (size_t)(row0 + ai * 128 + m * 16) * GC + bj * 128));
#pragma unroll
            for (int m = 0; m < 4; ++m) {
                const int row = row0 + ai * 128 + m * 16;
#pragma unroll
                for (int bj = 0; bj < 2; ++bj) {
                    const u32x4 gw = gv[m][bj];
                    const f32x4 a0 = (f32x4){bf_lo(gw.x), bf_hi(gw.x), bf_lo(gw.y), bf_hi(gw.y)}, a1 = (f32x4){bf_lo(gw.z), bf_hi(gw.z), bf_lo(gw.w), bf_hi(gw.w)};
                    const f32x4 v0 = acc[ai][bj][m][0] * a0, v1 = acc[ai][bj][m][1] * a1;
                    if (u.sub == 0) { acc[ai][bj][m][0] = v0; acc[ai][bj][m][1] = v1; }
                    else { u32x4 w; w.x = cvt_pk_bf16(v0[0], v0[1]); w.y = cvt_pk_bf16(v0[2], v0[3]); w.z = cvt_pk_bf16(v1[0], v1[1]); w.w = cvt_pk_bf16(v1[2], v1[3]);
                        *(u32x4*)(MRG + (size_t)row * D + colt + bj * 128) = w; }
                }
            }
        }
        return u.sub == 0;
    }
};

__device__ __forceinline__ void tr_item(const float* W, int ldw, int src_col0, int k0, bf16_t* dst, int dpitch, int drow0, const float* gain, float scale, LAS float* scr, int lane) {
    float wv[32];
    const float* wp = W + (size_t)(k0 + (lane >> 5)) * ldw + src_col0 + (lane & 31);
#pragma unroll
    for (int i = 0; i < 32; ++i) wv[i] = wp[(size_t)(2 * i) * ldw];
#pragma unroll
    for (int i = 0; i < 32; ++i) { const int kk = 2 * i + (lane >> 5); const float gv = gain ? gain[k0 + kk] * scale : scale;
        scr[kk * 33 + (lane & 31)] = wv[i] * gv; }
    LDS_WAIT(); asm volatile("" ::: "memory");
    const int c = lane & 7;
#pragma unroll
    for (int j = 0; j < 4; ++j) { const int n = (lane >> 3) + 8 * j; const LAS float* s = scr + (8 * c) * 33 + n;
        u32x4 o; o.x = pk2(s[0 * 33], s[1 * 33]); o.y = pk2(s[2 * 33], s[3 * 33]); o.z = pk2(s[4 * 33], s[5 * 33]); o.w = pk2(s[6 * 33], s[7 * 33]);
        *(u32x4*)(dst + (size_t)(drow0 + n) * dpitch + k0 + 8 * c) = o; }
    LDS_WAIT(); asm volatile("" ::: "memory");
}

struct Args { const float* in[20]; float* out; unsigned char* ws; int ph_lo, ph_hi; };

__device__ __forceinline__ void prep_phase(const Args& a, LAS unsigned char* lds) {
    const int tid = threadIdx.x, lane = tid & 63, wave = __builtin_amdgcn_readfirstlane(tid >> 6);
    const int gw = blockIdx.x * 8 + wave, NGW = gridDim.x * 8;
    LAS float* scr = (LAS float*)(lds + wave * 16384);
    unsigned char* ws = a.ws;
    constexpr int I_W13 = 16 * 88, I_W2 = 44 * 32, I_IN = 16 * 152, I_P = 8 * 32, I_O = 16 * 32;
    constexpr int I_FFN = 2 * I_W13 + I_W2;
    constexpr int NIT = 2 * I_FFN + I_IN + 2 * I_P + I_O;
    for (int it = gw; it < NIT; it += NGW) {
        int r = it;
        if (r < 2 * I_FFN) {
            const int f = r >= I_FFN; if (f) r -= I_FFN;
            const float* nrm = f ? a.in[16] : a.in[2]; const float* w1 = f ? a.in[17] : a.in[3]; const float* w3 = f ? a.in[18] : a.in[4]; const float* w2 = f ? a.in[19] : a.in[5];
            bf16_t* W13 = (bf16_t*)(ws + (f ? WS_W13B : WS_W13A)); bf16_t* W2 = (bf16_t*)(ws + (f ? WS_W2B : WS_W2A));
            if (r < 2 * I_W13) { const int up = r >= I_W13; if (up) r -= I_W13; const int kb = r / 88, nb = r % 88, n = 32 * nb;
                tr_item(up ? w3 : w1, FF, n, 64 * kb, W13, D, 256 * (n >> 7) + (n & 127) + (up ? 128 : 0), nrm, 1.f, scr, lane); }
            else { r -= 2 * I_W13; const int kb = r / 32, nb = r % 32; tr_item(w2, D, 32 * nb, 64 * kb, W2, FF, 32 * nb, nullptr, 1.f, scr, lane); }
            continue;
        }
        r -= 2 * I_FFN;
        if (r < I_IN) { const int kb = r / 152, nb = r % 152, dr = 32 * nb; const int gw_ = dr - 2816;
            const int sc = dr < 2048 ? dr : dr < 2816 ? dr + 16 : (((gw_ >> 7) & 1) ? 3856 : 2832) + 128 * (gw_ >> 8) + (gw_ & 127);
            tr_item(a.in[7], INC, sc, 64 * kb, (bf16_t*)(ws + WS_WIN), D, dr, a.in[6], (dr >= 512 && dr < 1024) ? 0.08838834764831845f : 1.f, scr, lane); continue; }
        r -= I_IN;
        if (r < 2 * I_P) { const int pa = r >= I_P; if (pa) r -= I_P; const int kb = r / 32, nb = r % 32;
            tr_item(pa ? a.in[14] : a.in[13], D, 32 * nb, 64 * kb, (bf16_t*)(ws + (pa ? WS_WPA : WS_WPM)), 512, 32 * nb, nullptr, 1.f, scr, lane); continue; }
        r -= 2 * I_P;
        { const int kb = r / 32, nb = r % 32; tr_item(a.in[15], D, 32 * nb, 64 * kb, (bf16_t*)(ws + WS_WOUT), D, 32 * nb, nullptr, 1.f, scr, lane); }
    }
    const int gt = blockIdx.x * NTHREADS + tid, NGT = gridDim.x * NTHREADS;
    if (gt == 0) *(unsigned*)(ws + WS_CTR) = 0u;
    for (int idx = gt; idx < 16 * D; idx += NGT) { const int g = idx >> 10, k = idx & 1023;
        ((bf16_t*)(ws + WS_WG))[idx] = (bf16_t)f2bf(a.in[7][(size_t)k * INC + 2048 + g] * a.in[6][k]); }
    for (int idx = gt; idx < 4096 * 32; idx += NGT) { const int pos = idx >> 5, i = idx & 31;
        double inv = 1.0; for (int q = 0; q < i; ++q) inv *= 0.74989420933245582730;
        const double ang = (double)pos * inv;
        const double qd = __builtin_rint(ang * 0.63661977236758134308);
        double rr = __builtin_fma(-qd, 1.5707963267948966, ang); rr = __builtin_fma(-qd, 6.123233995736766e-17, rr);
        const double r2 = rr * rr;
        const double sn = rr * (1.0 + r2 * (-1.0 / 6 + r2 * (1.0 / 120 + r2 * (-1.0 / 5040 + r2 * (1.0 / 362880 + r2 * (-1.0 / 39916800 + r2 * (1.0 / 6227020800.0)))))));
        const double cs = 1.0 + r2 * (-0.5 + r2 * (1.0 / 24 + r2 * (-1.0 / 720 + r2 * (1.0 / 40320 + r2 * (-1.0 / 3628800 + r2 * (1.0 / 479001600.0 + r2 * (-1.0 / 87178291200.0)))))));
        const int qn = ((int)qd) & 3;
        const double c = qn == 0 ? cs : qn == 1 ? -sn : qn == 2 ? -cs : sn;
        const double s = qn == 0 ? sn : qn == 1 ? cs : qn == 2 ? -sn : -cs;
        ((float2*)(ws + WS_ROPE))[idx] = make_float2((float)c, (float)s); }
    bf16_t* XB = (bf16_t*)(ws + WS_XB); float* PS0 = (float*)(ws + WS_PS0);
    for (int row0 = gw; row0 < T; row0 += 4 * NGW) {
        f32x4 v[4][4];
#pragma unroll
        for (int r = 0; r < 4; ++r) { const int row = row0 + r * NGW; if (row < T) {
            const float* xr = row < T_P ? a.in[0] + (size_t)row * D : a.in[1] + (size_t)(row - T_P) * D; const f32x4* x4 = (const f32x4*)xr + lane;
#pragma unroll
            for (int j = 0; j < 4; ++j) v[r][j] = __builtin_nontemporal_load(x4 + 64 * j); } }
#pragma unroll
        for (int r = 0; r < 4; ++r) { const int row = row0 + r * NGW; if (row < T) {
            float sq = 0.f;
#pragma unroll
            for (int j = 0; j < 4; ++j) sq += (v[r][j].x * v[r][j].x + v[r][j].y * v[r][j].y) + (v[r][j].z * v[r][j].z + v[r][j].w * v[r][j].w);
#pragma unroll
            for (int o = 1; o < 64; o <<= 1) sq += __shfl_xor(sq, o);
            u32x2* o8 = (u32x2*)(XB + (size_t)row * D) + lane;
#pragma unroll
            for (int j = 0; j < 4; ++j) { u32x2 w; w.x = pk2(v[r][j].x, v[r][j].y); w.y = pk2(v[r][j].z, v[r][j].w); o8[64 * j] = w; }
            if (lane == 0) { PS0[row] = sq; ((float*)(ws + WS_PS1))[row] = 0.f; ((float*)(ws + WS_PS2))[row] = 0.f; } } }
    }
}

__device__ __forceinline__ void gates_phase(const Args& a) {
    const int tid = threadIdx.x, lane = tid & 63, wave = __builtin_amdgcn_readfirstlane(tid >> 6), g = lane >> 4, c16 = lane & 15;
    const int gw = blockIdx.x * 8 + wave, NGW = gridDim.x * 8;
    const bf16_t* XB = (const bf16_t*)(a.ws + WS_XB); const bf16_t* WG = (const bf16_t*)(a.ws + WS_WG);
    const float* PS1 = (const float*)(a.ws + WS_PS1); float* GATES = (float*)(a.ws + WS_GATES);
    const float bias = a.in[8][c16]; const bool isf = (c16 >> 2) & 1;
    for (int it = gw; it < T / 16; it += NGW) {
        const int r0 = it * 16; f32x4 acc = {0.f, 0.f, 0.f, 0.f};
        const bf16_t* ap = XB + (size_t)(r0 + c16) * D + 8 * g; const bf16_t* bp = WG + (size_t)c16 * D + 8 * g;
#pragma unroll 8
        for (int kk = 0; kk < 32; ++kk) { const bf16x8 av = *(const bf16x8*)(ap + 32 * kk); const bf16x8 bv = *(const bf16x8*)(bp + 32 * kk); acc = mfma16(av, bv, acc); }
#pragma unroll
        for (int j = 0; j < 4; ++j) { const int row = r0 + 4 * g + j; float v = acc[j] * row_rs(PS1, row) + bias;
            if (isf) v = fminf(v, 0.f) - log1pf(__expf(-fabsf(v)));
            GATES[(size_t)row * 16 + c16] = v; }
    }
}

typedef short s16x4 __attribute__((ext_vector_type(4)));
#define DPP_F(oldv, src, ctrl, rmask) __int_as_float(__builtin_amdgcn_update_dpp(__float_as_int(oldv), __float_as_int(src), (ctrl), (rmask), 0xf, false))
__device__ __forceinline__ float wave_scan_add(float v) {
    v += DPP_F(0.f, v, 0x111, 0xf); v += DPP_F(0.f, v, 0x112, 0xf); v += DPP_F(0.f, v, 0x114, 0xf); v += DPP_F(0.f, v, 0x118, 0xf);
    v += DPP_F(0.f, v, 0x142, 0xa); v += DPP_F(0.f, v, 0x143, 0xc); return v;
}
__device__ __forceinline__ float wave_scan_max(float v) {
    const float ninf = -3.0e38f;
    v = fmaxf(v, DPP_F(ninf, v, 0x111, 0xf)); v = fmaxf(v, DPP_F(ninf, v, 0x112, 0xf)); v = fmaxf(v, DPP_F(ninf, v, 0x114, 0xf)); v = fmaxf(v, DPP_F(ninf, v, 0x118, 0xf));
    v = fmaxf(v, DPP_F(ninf, v, 0x142, 0xa)); v = fmaxf(v, DPP_F(ninf, v, 0x143, 0xc)); return v;
}
__device__ __forceinline__ float lane63(float v) { return __int_as_float(__builtin_amdgcn_readlane(__float_as_int(v), 63)); }
constexpr int ML_PQ = 272, ML_PV = 304, ML_PW = 144;
constexpr int ML_TSET = 54272;
constexpr int ML_Q = 0, ML_K = 17408, ML_V = 34816, ML_WQ = 2 * ML_TSET, ML_CT = ML_WQ + 9216, ML_SC = ML_CT + 39168, ML_MISC = ML_SC + 3 * 2048;
static_assert(ML_MISC + 256 <= LDS_BYTES, "mLSTM LDS map");
constexpr int SC_ROWS = 0, SC_W2 = 64, SC_SINT = 128, SC_EMT = 192, SC_SOLD = 256;
#define LBAR() asm volatile("s_waitcnt lgkmcnt(0)\n\ts_barrier" ::: "memory")
__device__ __forceinline__ bf16x8 tr_frag(LAS unsigned char* p, int pitch) {
    const s16x4 lo = __builtin_amdgcn_ds_read_tr16_b64_v4i16((LAS s16x4*)p);
    const s16x4 hi = __builtin_amdgcn_ds_read_tr16_b64_v4i16((LAS s16x4*)(p + 4 * pitch));
    return (bf16x8){lo[0], lo[1], lo[2], lo[3], hi[0], hi[1], hi[2], hi[3]};
}
__device__ __forceinline__ void mlstm_chain(LAS unsigned char* lds, const bf16_t* Z, const float* GATES, bf16_t* HOUT, int rowbase, int S, int head, int dir) {
    const int tid = threadIdx.x, lane = tid & 63, wave = __builtin_amdgcn_readfirstlane(tid >> 6), g = lane >> 4, c16 = lane & 15;
    LAS unsigned char* WQ = lds + ML_WQ; LAS unsigned char* CT = lds + ML_CT;
    const int trKo = ML_K + (8 * g + (c16 >> 2)) * ML_PQ + 8 * (lane & 3);
    const int trVo = ML_V + (8 * g + (c16 >> 2)) * ML_PV + 8 * (lane & 3);
    f32x4 st[9];
#pragma unroll
    for (int i = 0; i < 9; ++i) st[i] = (f32x4){0.f, 0.f, 0.f, 0.f};
    float m_prev = -1e30f, gli = 0.f, glf = 0.f;
    for (int i = tid; i < 2 * 64 * 8; i += NTHREADS) { const int ts = i >> 9, r = (i >> 3) & 63, wd = i & 7;
        *(LAS unsigned*)(lds + ts * ML_TSET + ML_V + r * ML_PV + 256 + wd * 4) = wd == 0 ? 0x3F80u : 0u; }
    for (int i = tid; i < 9216 / 16; i += NTHREADS) { const u32x4 z = {0u, 0u, 0u, 0u}; *(LAS u32x4*)(WQ + i * 16) = z; }
    const int NC = S >> 6;
    const bf16_t* zsrc = Z + (size_t)rowbase * ZC + head * 128;
    u32x4 rq[2], rk[2], rv[2];
#define ML_LOAD_TILES(cc) do { const int _oc = dir ? NC - 1 - (cc) : (cc); _Pragma("unroll") for (int i = 0; i < 2; ++i) { const int p = tid + NTHREADS * i, to = p >> 4, cp = p & 15; \
        const bf16_t* src = zsrc + (size_t)(_oc * 64 + to) * ZC + cp * 8; rq[i] = *(const u32x4*)src; rk[i] = *(const u32x4*)(src + 512); rv[i] = *(const u32x4*)(src + 1024); } } while (0)
#define ML_LOAD_GATES(cc) do { const int _oc = dir ? NC - 1 - (cc) : (cc); const int to = dir ? 63 - lane : lane; \
        const float* gp = GATES + (size_t)(rowbase + _oc * 64 + to) * 16 + dir * 8 + head; gli = gp[0]; glf = gp[4]; } while (0)
#define ML_SCAN(scp) do { const float b = wave_scan_add(glf); \
        const float gsum = lane63(b); const float lmb = gli - b; const float pm = wave_scan_max(lmb); \
        const float mloc = gsum + lane63(pm); const float m_new = fmaxf(gsum + m_prev, mloc); \
        const float m_inter = b + m_prev, m_t = fmaxf(b + pm, m_inter); \
        (scp)[SC_ROWS + lane] = __expf(fminf(b - m_t - gsum + m_new, 80.f)); (scp)[SC_W2 + lane] = __expf(gsum + lmb - m_new); \
        (scp)[SC_SINT + lane] = __expf(m_inter - m_t); (scp)[SC_EMT + lane] = __expf(-m_t); \
        if (lane == 0) (scp)[SC_SOLD] = __expf(gsum + m_prev - m_new); \
        m_prev = m_new; } while (0)
#define ML_WRITE_TILES(tset, scp) do { _Pragma("unroll") for (int i = 0; i < 2; ++i) { const int p = tid + NTHREADS * i, to = p >> 4, cp = p & 15; const int tl = dir ? 63 - to : to; \
        const float w2 = (scp)[SC_W2 + tl]; u32x4 kw; \
        _Pragma("unroll") for (int jj = 0; jj < 4; ++jj) kw[jj] = pk2(bf_lo(rk[i][jj]) * w2, bf_hi(rk[i][jj]) * w2); \
        *(LAS u32x4*)((tset) + ML_Q + tl * ML_PQ + cp * 16) = rq[i]; *(LAS u32x4*)((tset) + ML_K + tl * ML_PQ + cp * 16) = kw; *(LAS u32x4*)((tset) + ML_V + tl * ML_PV + cp * 16) = rv[i]; } } while (0)
    ML_LOAD_TILES(0);
    if (wave == 0) { ML_LOAD_GATES(0); ML_SCAN((LAS float*)(lds + ML_SC)); if (NC > 1) ML_LOAD_GATES(1); }
    LBAR();
    ML_WRITE_TILES(lds, (LAS float*)(lds + ML_SC));
    if (NC > 1) { ML_LOAD_TILES(1); if (wave == 0) { ML_SCAN((LAS float*)(lds + ML_SC + 2048)); if (NC > 2) ML_LOAD_GATES(2); } }
    LBAR();
    const int e0 = wave, e1 = wave + 8;
    const int ti0 = e0 >= 6 ? 3 : e0 >= 3 ? 2 : e0 >= 1 ? 1 : 0, si0 = e0 - ti0 * (ti0 + 1) / 2;
    const int ti1 = 3, si1 = e1 - 6;
    int sci = 0;
    for (int c = 0; c < NC; ++c) {
        const int oc = dir ? NC - 1 - c : c; const int crow0 = rowbase + oc * 64;
        LAS unsigned char* tset = lds + (c & 1) * ML_TSET;
        LAS unsigned char* Qs = tset + ML_Q; LAS unsigned char* Ks = tset + ML_K;
        LAS unsigned char* trK = tset + trKo; LAS unsigned char* trV = tset + trVo;
        LAS float* sc = (LAS float*)(lds + ML_SC + sci * 2048);
        const int sc1 = sci == 2 ? 0 : sci + 1, sc2 = sc1 == 2 ? 0 : sc1 + 1;
#pragma unroll
        for (int vt = 0; vt < 9; ++vt) { u32x2 w; w.x = pk2(st[vt][0], st[vt][1]); w.y = pk2(st[vt][2], st[vt][3]);
            *(LAS u32x2*)(CT + (16 * vt + c16) * ML_PQ + (16 * wave + 4 * g) * 2) = w; }
        {
            const int nq = wave < 2 ? 2 : 1;
            bf16x8 sa[2][4], sb[2][4];
#pragma unroll
            for (int q = 0; q < 2; ++q) { if (q < nq) { const int ti = q ? ti1 : ti0, si = q ? si1 : si0;
#pragma unroll
                for (int kk = 0; kk < 4; ++kk) { sa[q][kk] = *(const LAS bf16x8*)(Ks + (16 * si + c16) * ML_PQ + (32 * kk + 8 * g) * 2);
                    sb[q][kk] = *(const LAS bf16x8*)(Qs + (16 * ti + c16) * ML_PQ + (32 * kk + 8 * g) * 2); } } }
            __builtin_amdgcn_sched_barrier(0);
#pragma unroll
            for (int q = 0; q < 2; ++q) { if (q < nq) { const int ti = q ? ti1 : ti0, si = q ? si1 : si0;
                f32x4 acc = {0.f, 0.f, 0.f, 0.f};
#pragma unroll
                for (int kk = 0; kk < 4; ++kk) acc = mfma16(sa[q][kk], sb[q][kk], acc);
                const int t = 16 * ti + c16, s0 = 16 * si + 4 * g; const float rsc = sc[SC_ROWS + t];
                u32x2 w; w.x = pk2(s0 <= t ? rsc * acc[0] : 0.f, s0 + 1 <= t ? rsc * acc[1] : 0.f); w.y = pk2(s0 + 2 <= t ? rsc * acc[2] : 0.f, s0 + 3 <= t ? rsc * acc[3] : 0.f);
                *(LAS u32x2*)(WQ + t * ML_PW + s0 * 2) = w; } }
        }
        {
            const float s_old = sc[SC_SOLD];
            bf16x8 ak[2];
#pragma unroll
            for (int kk = 0; kk < 2; ++kk) ak[kk] = tr_frag(trK + (32 * kk) * ML_PQ + (16 * wave) * 2, ML_PQ);
#pragma unroll
            for (int hb = 0; hb < 2; ++hb) {
                bf16x8 bvv[5][2];
#pragma unroll
                for (int v5 = 0; v5 < 5; ++v5) { const int vt = hb * 5 + v5; if (vt < 9) {
#pragma unroll
                    for (int kk = 0; kk < 2; ++kk) bvv[v5][kk] = tr_frag(trV + (32 * kk) * ML_PV + (16 * vt) * 2, ML_PV); } }
                __builtin_amdgcn_sched_barrier(0);
#pragma unroll
                for (int v5 = 0; v5 < 5; ++v5) { const int vt = hb * 5 + v5; if (vt < 9) { st[vt] = st[vt] * s_old;
#pragma unroll
                    for (int kk = 0; kk < 2; ++kk) st[vt] = mfma16(ak[kk], bvv[v5][kk], st[vt]); } }
                __builtin_amdgcn_sched_barrier(0);
            }
        }
        LBAR();
        {
            const int tt = wave & 3, vh = wave >> 2;
            bf16x8 aw[2], aq[4];
#pragma unroll
            for (int kk = 0; kk < 2; ++kk) aw[kk] = *(const LAS bf16x8*)(WQ + (16 * tt + c16) * ML_PW + (32 * kk + 8 * g) * 2);
#pragma unroll
            for (int kk = 0; kk < 4; ++kk) aq[kk] = *(const LAS bf16x8*)(Qs + (16 * tt + c16) * ML_PQ + (32 * kk + 8 * g) * 2);
            const int t = 16 * tt + c16; const float sint = sc[SC_SINT + t], emt = sc[SC_EMT + t];
            f32x4 tot[5];
#pragma unroll
            for (int hb = 0; hb < 3; ++hb) {
                bf16x8 fv[2][2], fc[2][4];
#pragma unroll
                for (int q3 = 0; q3 < 2; ++q3) { const int q = hb * 2 + q3; if (q < 5) { const int vt = (q == 4) ? 8 : 4 * vh + q;
#pragma unroll
                    for (int kk = 0; kk < 2; ++kk) fv[q3][kk] = tr_frag(trV + (32 * kk) * ML_PV + (16 * vt) * 2, ML_PV);
#pragma unroll
                    for (int kk = 0; kk < 4; ++kk) fc[q3][kk] = *(const LAS bf16x8*)(CT + (16 * vt + c16) * ML_PQ + (32 * kk + 8 * g) * 2); } }
                __builtin_amdgcn_sched_barrier(0);
#pragma unroll
                for (int q3 = 0; q3 < 2; ++q3) { const int q = hb * 2 + q3; if (q < 5) { f32x4 ai = {0.f, 0.f, 0.f, 0.f}, ax = {0.f, 0.f, 0.f, 0.f};
#pragma unroll
                    for (int kk = 0; kk < 2; ++kk) ai = mfma16(fv[q3][kk], aw[kk], ai);
#pragma unroll
                    for (int kk = 0; kk < 4; ++kk) ax = mfma16(fc[q3][kk], aq[kk], ax);
                    tot[q] = ai + sint * ax; } }
                __builtin_amdgcn_sched_barrier(0);
            }
            const float den = __shfl(tot[4][0], c16);
            const float inv = rcpf_(fmaxf(fabsf(den), emt));
            const int to = dir ? 63 - t : t;
            bf16_t* hp = HOUT + (size_t)(crow0 + to) * 512 + head * 128 + 4 * g;
#pragma unroll
            for (int q = 0; q < 4; ++q) { const int vt = 4 * vh + q; u32x2 w; w.x = pk2(tot[q][0] * inv, tot[q][1] * inv); w.y = pk2(tot[q][2] * inv, tot[q][3] * inv);
                *(u32x2*)(hp + 16 * vt) = w; }
        }
        if (c + 1 < NC) ML_WRITE_TILES(lds + ((c + 1) & 1) * ML_TSET, (LAS float*)(lds + ML_SC + sc1 * 2048));
        if (c + 2 < NC) { ML_LOAD_TILES(c + 2); if (wave == 0) { ML_SCAN((LAS float*)(lds + ML_SC + sc2 * 2048)); if (c + 3 < NC) ML_LOAD_GATES(c + 3); } }
        sci = sc1;
        LBAR();
    }
#undef ML_LOAD_TILES
#undef ML_LOAD_GATES
#undef ML_SCAN
#undef ML_WRITE_TILES
}

constexpr int AT_PK = 144, AT_K = 0, AT_V = 384 * AT_PK;
__device__ __forceinline__ void attn_item(LAS unsigned char* lds, bf16_t* Z, const float2* ROPE, const float* q_norm, const float* k_norm, const float* sink, int it) {
    const int tid = threadIdx.x, lane = tid & 63, wave = __builtin_amdgcn_readfirstlane(tid >> 6), g = lane >> 4, c16 = lane & 15;
    const int bg = it >> 1, kvh = it & 1, row0 = bg * 128;
    int pos0, S; if (row0 < T_P) { pos0 = row0 & 2047; S = 2048; } else { pos0 = (row0 - T_P) & 4095; S = 4096; }
    LAS unsigned char* Ks = lds + AT_K; LAS unsigned char* Vs = lds + AT_V;
    const int hq = kvh * 4 + (wave >> 1); const float snk = sink[hq];
    const int ko = tid & 3, kj0 = tid >> 2, vo = tid & 7, vj0 = tid >> 3;
    u32x4 klo[3], khi[3], vv[6];
#pragma unroll
    for (int i = 0; i < 6; ++i) { const int kj = vj0 + 64 * i, pos = pos0 - 128 + kj; const bool valid = pos >= 0 && pos < S;
        vv[i] = (u32x4){0u, 0u, 0u, 0u};
        if (valid) vv[i] = *(const u32x4*)(Z + (size_t)(row0 - 128 + kj) * ZC + 2688 + kvh * 64 + 8 * vo); }
    u32x4 qf0[4], qf1[4];
    {
        float qn1[8], qn2[8];
#pragma unroll
        for (int j = 0; j < 8; ++j) { qn1[j] = q_norm[8 * g + j]; qn2[j] = q_norm[32 + 8 * g + j]; }
        u32x4 qlo[4], qhi[4]; f32x4 qr[4][4];
#pragma unroll
        for (int qt = 0; qt < 4; ++qt) { const int qi = (wave & 1) * 64 + 16 * qt + c16; const bf16_t* qptr = Z + (size_t)(row0 + qi) * ZC + 2048 + hq * 64;
            qlo[qt] = *(const u32x4*)(qptr + 8 * g); qhi[qt] = *(const u32x4*)(qptr + 32 + 8 * g);
        }
#pragma unroll
        for (int qt = 0; qt < 4; ++qt) {
            if ((qt & 1) == 0) {
#pragma unroll
                for (int q2 = 0; q2 < 2; ++q2) { const int qi2 = (wave & 1) * 64 + 16 * (qt + q2) + c16; const f32x4* rp = (const f32x4*)(ROPE + (size_t)(pos0 + qi2) * 32 + 8 * g);
#pragma unroll
                    for (int k = 0; k < 4; ++k) qr[qt + q2][k] = rp[k]; } }
            float x1[8], x2[8];
#pragma unroll
            for (int jj = 0; jj < 4; ++jj) { x1[2 * jj] = bf_lo(qlo[qt][jj]); x1[2 * jj + 1] = bf_hi(qlo[qt][jj]); x2[2 * jj] = bf_lo(qhi[qt][jj]); x2[2 * jj + 1] = bf_hi(qhi[qt][jj]); }
            float ss = 0.f;
#pragma unroll
            for (int j = 0; j < 8; ++j) ss += x1[j] * x1[j] + x2[j] * x2[j];
            ss += __shfl_xor(ss, 16); ss += __shfl_xor(ss, 32);
            const float rs = rsqrtf(ss * (1.f / 64.f) + EPS) * (0.125f * 1.4426950408889634f);
            float y1[8], y2[8];
#pragma unroll
            for (int j = 0; j < 8; ++j) { const float av = x1[j] * rs * qn1[j], bv = x2[j] * rs * qn2[j]; const float cs = qr[qt][j >> 1][(j & 1) * 2], sn = qr[qt][j >> 1][(j & 1) * 2 + 1];
                y1[j] = av * cs - bv * sn; y2[j] = bv * cs + av * sn; }
#pragma unroll
            for (int jj = 0; jj < 4; ++jj) { qf0[qt][jj] = pk2(y1[2 * jj], y1[2 * jj + 1]); qf1[qt][jj] = pk2(y2[2 * jj], y2[2 * jj + 1]); }
        }
    }
    {
#pragma unroll
    for (int i = 0; i < 3; ++i) { const int kj = kj0 + 128 * i, pos = pos0 - 128 + kj; const bool valid = pos >= 0 && pos < S;
        klo[i] = (u32x4){0u, 0u, 0u, 0u}; khi[i] = klo[i];
        if (valid) { const bf16_t* src = Z + (size_t)(row0 - 128 + kj) * ZC + 2560 + kvh * 64 + 8 * ko; klo[i] = *(const u32x4*)src; khi[i] = *(const u32x4*)(src + 32); } }
        float kn1[8], kn2[8];
#pragma unroll
        for (int j = 0; j < 8; ++j) { kn1[j] = k_norm[8 * ko + j]; kn2[j] = k_norm[32 + 8 * ko + j]; }
        f32x4 kr[3][4];
#pragma unroll
        for (int i = 0; i < 3; ++i) { const int kj = kj0 + 128 * i, pos = pos0 - 128 + kj; const int pc = (pos >= 0 && pos < S) ? pos : 0;
            const f32x4* rp = (const f32x4*)(ROPE + (size_t)pc * 32 + 8 * ko);
#pragma unroll
            for (int k = 0; k < 4; ++k) kr[i][k] = rp[k]; }
#pragma unroll
        for (int i = 0; i < 3; ++i) { const int kj = kj0 + 128 * i;
            float x1[8], x2[8];
#pragma unroll
            for (int jj = 0; jj < 4; ++jj) { x1[2 * jj] = bf_lo(klo[i][jj]); x1[2 * jj + 1] = bf_hi(klo[i][jj]); x2[2 * jj] = bf_lo(khi[i][jj]); x2[2 * jj + 1] = bf_hi(khi[i][jj]); }
            float ss = 0.f;
#pragma unroll
            for (int j = 0; j < 8; ++j) ss += x1[j] * x1[j] + x2[j] * x2[j];
            ss += __shfl_xor(ss, 1); ss += __shfl_xor(ss, 2);
            const float rs = rsqrtf(ss * (1.f / 64.f) + EPS);
            float y1[8], y2[8];
#pragma unroll
            for (int j = 0; j < 8; ++j) { const float av = x1[j] * rs * kn1[j], bv = x2[j] * rs * kn2[j]; const float cs = kr[i][j >> 1][(j & 1) * 2], sn = kr[i][j >> 1][(j & 1) * 2 + 1];
                y1[j] = av * cs - bv * sn; y2[j] = bv * cs + av * sn; }
            u32x4 w1, w2;
#pragma unroll
            for (int jj = 0; jj < 4; ++jj) { w1[jj] = pk2(y1[2 * jj], y1[2 * jj + 1]); w2[jj] = pk2(y2[2 * jj], y2[2 * jj + 1]); }
            *(LAS u32x4*)(Ks + kj * AT_PK + 16 * ko) = w1; *(LAS u32x4*)(Ks + kj * AT_PK + 64 + 16 * ko) = w2; }
#pragma unroll
        for (int i = 0; i < 6; ++i) *(LAS u32x4*)(Vs + (vj0 + 64 * i) * AT_PK + 16 * vo) = vv[i];
    }
    __syncthreads();
    LAS unsigned char* trP = Vs + (4 * g + (c16 >> 2)) * AT_PK + 8 * (lane & 3);
#pragma unroll 1
    for (int qt = 0; qt < 4; ++qt) {
        const int q0 = (wave & 1) * 64 + 16 * qt, qi = q0 + c16;
        const bf16x8 qa = __builtin_bit_cast(bf16x8, qf0[0]), qb = __builtin_bit_cast(bf16x8, qf1[0]);
        const int ks0 = q0 & ~31;
        f32x4 s[18]; float mx = -1e30f;
        const float snk2 = snk * 1.4426950408889634f;
#pragma unroll
        for (int i = 0; i < 18; ++i) { const int kb = ks0 + 16 * i;
            const int kp0 = pos0 - 128 + kb; const bool dead = kb < q0 || kb > q0 + 256 || kp0 < 0 || kp0 >= S;
            f32x4 acc = {-1e30f, -1e30f, -1e30f, -1e30f};
            if (!dead) {
                const bf16x8 a0 = *(const LAS bf16x8*)(Ks + (kb + c16) * AT_PK + 16 * g), a1 = *(const LAS bf16x8*)(Ks + (kb + c16) * AT_PK + 64 + 16 * g);
                acc = (f32x4){0.f, 0.f, 0.f, 0.f}; acc = mfma16(a0, qa, acc); acc = mfma16(a1, qb, acc);
                if (kb == q0) {
#pragma unroll
                    for (int j = 0; j < 4; ++j) acc[j] = (4 * g + j >= c16) ? acc[j] : -1e30f; }
                if (kb == q0 + 256) {
#pragma unroll
                    for (int j = 0; j < 4; ++j) acc[j] = (4 * g + j <= c16) ? acc[j] : -1e30f; }
                mx = fmaxf(mx, fmaxf(fmaxf(acc[0], acc[1]), fmaxf(acc[2], acc[3])));
            }
            s[i] = acc; }
        mx = fmaxf(mx, __shfl_xor(mx, 16)); mx = fmaxf(mx, __shfl_xor(mx, 32)); mx = fmaxf(mx, snk2);
        float sum = 0.f;
#pragma unroll
        for (int i = 0; i < 18; ++i) { const int kb = ks0 + 16 * i; const int kp0 = pos0 - 128 + kb; const bool dead = kb < q0 || kb > q0 + 256 || kp0 < 0 || kp0 >= S;
            if (!dead) {
#pragma unroll
                for (int j = 0; j < 4; ++j) { const float p = __builtin_amdgcn_exp2f(s[i][j] - mx); s[i][j] = p; sum += p; } }
            else s[i] = (f32x4){0.f, 0.f, 0.f, 0.f}; }
        sum += __shfl_xor(sum, 16); sum += __shfl_xor(sum, 32);
        const float inv = rcpf_(sum + __builtin_amdgcn_exp2f(snk2 - mx));
        f32x4 o[4];
#pragma unroll
        for (int dt = 0; dt < 4; ++dt) o[dt] = (f32x4){0.f, 0.f, 0.f, 0.f};
#pragma unroll
        for (int kk = 0; kk < 9; ++kk) {
            u32x4 pw; pw.x = pk2(s[2 * kk][0] * inv, s[2 * kk][1] * inv); pw.y = pk2(s[2 * kk][2] * inv, s[2 * kk][3] * inv);
            pw.z = pk2(s[2 * kk + 1][0] * inv, s[2 * kk + 1][1] * inv); pw.w = pk2(s[2 * kk + 1][2] * inv, s[2 * kk + 1][3] * inv);
            const bf16x8 pb = __builtin_bit_cast(bf16x8, pw);
#pragma unroll
            for (int dt = 0; dt < 4; ++dt) { LAS unsigned char* vp = trP + (ks0 + 32 * kk) * AT_PK + (16 * dt) * 2;
                const s16x4 v0 = __builtin_amdgcn_ds_read_tr16_b64_v4i16((LAS s16x4*)vp), v1 = __builtin_amdgcn_ds_read_tr16_b64_v4i16((LAS s16x4*)(vp + 16 * AT_PK));
                const bf16x8 av = (bf16x8){v0[0], v0[1], v0[2], v0[3], v1[0], v1[1], v1[2], v1[3]};
                o[dt] = mfma16(av, pb, o[dt]); }
        }
        bf16_t* qptr = Z + (size_t)(row0 + qi) * ZC + 2048 + hq * 64;
#pragma unroll
        for (int dt = 0; dt < 4; ++dt) { u32x2 w; w.x = pk2_sw(o[dt][0], o[dt][1]); w.y = pk2_sw(o[dt][2], o[dt][3]); *(u32x2*)(qptr + 16 * dt + 4 * g) = w; }
        qf0[0] = qf0[1]; qf0[1] = qf0[2]; qf0[2] = qf0[3]; qf1[0] = qf1[1]; qf1[1] = qf1[2]; qf1[2] = qf1[3];
    }
    __syncthreads();
}

__device__ __forceinline__ void mix_phase(const Args& a, LAS unsigned char* lds) {
    bf16_t* Z = (bf16_t*)(a.ws + WS_R1); const float* GATES = (const float*)(a.ws + WS_GATES); bf16_t* HFB = (bf16_t*)(a.ws + WS_HFB);
    for (int it = blockIdx.x; it < 320; it += gridDim.x) {
        int rowbase, S, head, dir;
        if (it >= 64 && it < 128) { const int c2 = it - 64; const int sq = c2 >> 3; head = (c2 >> 1) & 3; dir = c2 & 1; rowbase = T_P + sq * 4096; S = 4096; }
        else { const int c2 = it < 64 ? it : it - 64; const int sq = c2 >> 3; head = (c2 >> 1) & 3; dir = c2 & 1; rowbase = sq * 2048; S = 2048; }
        mlstm_chain(lds, Z, GATES, HFB + (size_t)dir * T * 512, rowbase, S, head, dir);
    }
    unsigned* ctr = (unsigned*)(a.ws + WS_CTR);
    volatile LAS int* slot = (volatile LAS int*)(lds + ML_MISC);
    for (;;) {
        __syncthreads();
        if (threadIdx.x == 0) *slot = (int)atomicAdd(ctr, 1u);
        __syncthreads();
        const int it = *slot;
        if (it >= 1536) break;
        attn_item(lds, Z, (const float2*)(a.ws + WS_ROPE), a.in[10], a.in[11], a.in[12], it);
    }
}

__device__ __forceinline__ void norm_phase(const Args& a) {
    const int tid = threadIdx.x, lane = tid & 63, wave = __builtin_amdgcn_readfirstlane(tid >> 6);
    const int gw = blockIdx.x * 8 + wave, NGW = gridDim.x * 8;
    bf16_t* Z = (bf16_t*)(a.ws + WS_R1); const bf16_t* HF = (const bf16_t*)(a.ws + WS_HFB); const bf16_t* HB = HF + (size_t)T * 512;
    const float* mn = a.in[9] + 8 * lane; float mnv[8];
#pragma unroll
    for (int j = 0; j < 8; ++j) mnv[j] = mn[j];
    for (int row0 = gw; row0 < T; row0 += 4 * NGW) {
        u32x4 f[4], b[4], mo[4];
#pragma unroll
        for (int r = 0; r < 4; ++r) { const int row = row0 + r * NGW; if (row < T) {
            f[r] = *(const u32x4*)(HF + (size_t)row * 512 + 8 * lane); b[r] = *(const u32x4*)(HB + (size_t)row * 512 + 8 * lane); mo[r] = *(const u32x4*)(Z + (size_t)row * ZC + 1536 + 8 * lane); } }
#pragma unroll
        for (int r = 0; r < 4; ++r) { const int row = row0 + r * NGW; if (row < T) {
            float h[8], ss = 0.f;
#pragma unroll
            for (int jj = 0; jj < 4; ++jj) { h[2 * jj] = bf_lo(f[r][jj]) + bf_lo(b[r][jj]); h[2 * jj + 1] = bf_hi(f[r][jj]) + bf_hi(b[r][jj]); }
#pragma unroll
            for (int j = 0; j < 8; ++j) ss += h[j] * h[j];
            ss += __shfl_xor(ss, 1); ss += __shfl_xor(ss, 2); ss += __shfl_xor(ss, 4); ss += __shfl_xor(ss, 8);
            const float rs = rsqrtf(ss * (1.f / 128.f) + EPS);
            u32x4 w;
#pragma unroll
            for (int jj = 0; jj < 4; ++jj) w[jj] = pk2(h[2 * jj] * rs * mnv[2 * jj] * sigmoidf_(bf_lo(mo[r][jj])), h[2 * jj + 1] * rs * mnv[2 * jj + 1] * sigmoidf_(bf_hi(mo[r][jj])));
            *(u32x4*)(Z + (size_t)row * ZC + 1536 + 8 * lane) = w; } }
    }
}

#define XB_TMO      128
#define XB_XCNT(j)  (256  + 64 * (j))
#define XB_XSUB(j)  (1280 + 64 * (j))
#define XB_XGEN(j)  (2304 + 64 * (j))
#define XB_TOP      3328
#define XB_TOPGEN   3392
#define XCD_BAR_WORDS 3456
#define XB_SPIN_CAP (1u << 18)
__device__ __forceinline__ unsigned xb_ld(unsigned* p)              { return __hip_atomic_load(p, __ATOMIC_RELAXED, __HIP_MEMORY_SCOPE_AGENT); }
__device__ __forceinline__ unsigned xb_add(unsigned* p, unsigned v) { return __hip_atomic_fetch_add(p, v, __ATOMIC_RELAXED, __HIP_MEMORY_SCOPE_AGENT); }
__device__ __forceinline__ unsigned xb_xcc_id() { return (unsigned)__builtin_amdgcn_s_getreg((3 << 11) | 20) & 0xFu; }
#define XB_SPIN(cond, bar) do { unsigned _sp = 0; while (cond) { __builtin_amdgcn_s_sleep(1); \
    if ((++_sp & 255u) == 0u) { if (xb_ld(&(bar)[XB_TMO])) break; if (_sp > XB_SPIN_CAP) { atomicAdd(&(bar)[XB_TMO], 1u); break; } } } } while (0)
struct XcdBarrier { unsigned* bar; unsigned x; volatile LAS unsigned* st; };
__device__ __forceinline__ XcdBarrier xcd_barrier_post(unsigned* bar, volatile LAS unsigned* st) {
    XcdBarrier b; b.bar = bar; b.x = xb_xcc_id(); b.st = st;
    if (threadIdx.x == 0) (void)xb_add(&bar[XB_XCNT(b.x)], 1u);
    return b;
}
__device__ __forceinline__ void xcd_barrier_complete(unsigned* bar, unsigned x, unsigned& nloc, unsigned& nx) {
    const unsigned G = gridDim.x * gridDim.y * gridDim.z;
    unsigned sum, cnt, mine, sp = 0u;
    for (;;) {
        sum = 0u; cnt = 0u; mine = 0u;
#pragma unroll
        for (unsigned j = 0; j < 16; ++j) { const unsigned c = xb_ld(&bar[XB_XCNT(j)]); sum += c; cnt += (c > 0u) ? 1u : 0u; mine = (j == x) ? c : mine; }
        if (sum == G) break;
        __builtin_amdgcn_s_sleep(1);
        if ((++sp & 255u) == 0u) { if (xb_ld(&bar[XB_TMO])) break; if (sp > XB_SPIN_CAP) { atomicAdd(&bar[XB_TMO], 1u); break; } }
    }
    nloc = mine > 0u ? mine : 1u; nx = cnt > 0u ? cnt : 1u;
}
__device__ __forceinline__ void xcd_barrier(const XcdBarrier& b) {
    asm volatile("s_waitcnt vmcnt(0)" ::: "memory");
    __syncthreads();
    if (threadIdx.x == 0) {
        unsigned* bar = b.bar;
        __builtin_amdgcn_s_waitcnt(0);
        unsigned nloc = b.st[0], nx = b.st[1];
        if (nloc == 0u) { xcd_barrier_complete(bar, b.x, nloc, nx); b.st[0] = nloc; b.st[1] = nx; }
        const unsigned old = xb_add(&bar[XB_XSUB(b.x)], 1u);
        const unsigned gen = old / nloc;
        if (old + 1u == (gen + 1u) * nloc) {
            __builtin_amdgcn_fence(__ATOMIC_RELEASE, "agent");
            asm volatile("s_waitcnt vmcnt(0)" ::: "memory");
            const unsigned og = xb_add(&bar[XB_TOP], 1u);
            const unsigned tg = og / nx;
            if (og + 1u == (tg + 1u) * nx) xb_add(&bar[XB_TOPGEN], 1u);
            else XB_SPIN(xb_ld(&bar[XB_TOPGEN]) == tg, bar);
            __builtin_amdgcn_fence(__ATOMIC_ACQUIRE, "agent");
            xb_add(&bar[XB_XGEN(b.x)], 1u);
            asm volatile("s_waitcnt vmcnt(0)" ::: "memory");
        } else {
            XB_SPIN(xb_ld(&bar[XB_XGEN(b.x)]) == gen, bar);
            __builtin_amdgcn_fence(__ATOMIC_ACQUIRE, "agent");
            asm volatile("s_waitcnt vmcnt(0)" ::: "memory");
        }
    }
    __syncthreads();
}

__global__ void __launch_bounds__(NTHREADS, 2) mk_fwd(Args a) {
    extern __shared__ __attribute__((aligned(16))) unsigned char lds_raw[];
    LAS unsigned char* lds = (LAS unsigned char*)lds_raw;
    cg::grid_group grid = cg::this_grid();
    const int lo = a.ph_lo, hi = a.ph_hi, G = gridDim.x, c = blockIdx.x;
    unsigned char* ws = a.ws;
    bf16_t* XB = (bf16_t*)(ws + WS_XB); bf16_t* R1 = (bf16_t*)(ws + WS_R1); bf16_t* MRG = (bf16_t*)(ws + WS_HFB); bf16_t* ZG = (bf16_t*)a.out;
    float* PS0 = (float*)(ws + WS_PS0); float* PS1 = (float*)(ws + WS_PS1); float* PS2 = (float*)(ws + WS_PS2);
    constexpr int nM = T / 256;
#define IN(k) (lo <= (k) && (k) < hi)
#define SEAM(k) do { if (IN(k) && IN((k) + 1)) { if (lo < 0) grid.sync(); else xcd_barrier(xbar); } } while (0)
    volatile LAS unsigned* xst = (volatile LAS unsigned*)(lds + LDS_BYTES - 64);
    if (threadIdx.x < 2) xst[threadIdx.x] = 0u;
    __syncthreads();
    XcdBarrier xbar; xbar.bar = (unsigned*)(ws + WS_BAR); xbar.x = 0; xbar.st = xst;
    if (hi - lo > 1) xbar = xcd_barrier_post((unsigned*)(ws + WS_BAR), xst);
    if (IN(0)) { prep_phase(a, lds); __syncthreads(); }
    SEAM(0);
    if (IN(1)) {
        pg8::SchedPlain S{(const char*)XB, (const char*)(ws + WS_W13A), D, D, nM, 2 * FF / 256, G, c};
        EpiSwiglu E{PS0, R1}; pg8::gemm_phase(lds, D, D, D, S, E);
    }
    SEAM(1);
    if (IN(2)) {
        pg8::SchedPlain S{(const char*)R1, (const char*)(ws + WS_W2A), FF, FF, nM, D / 256, G, c};
        EpiRes<0> E{a.in[0], a.in[1], a.out, XB, PS1}; pg8::gemm_phase(lds, FF, FF, FF, S, E);
    }
    SEAM(2);
    if (IN(3)) {
        pg8::SchedPlain S{(const char*)XB, (const char*)(ws + WS_WIN), D, D, nM, 19, G, c};
        EpiIn E{PS1, R1, ZG}; pg8::gemm_phase(lds, D, D, D, S, E);
        gates_phase(a);
    }
    SEAM(3);
    if (IN(4)) mix_phase(a, lds);
    SEAM(4);
    if (IN(5)) norm_phase(a);
    SEAM(5);
    if (IN(6)) {
        pg8::SchedPair S{(const char*)(R1 + 1536), (const char*)(R1 + 2048), (const char*)(ws + WS_WPM), (const char*)(ws + WS_WPA), ZC, 512, nM, D / 256, G, c};
        EpiMerge E{ZG, MRG}; pg8::gemm_phase(lds, ZC, 512, 512, S, E);
    }
    SEAM(6);
    if (IN(7)) {
        pg8::SchedPlain S{(const char*)MRG, (const char*)(ws + WS_WOUT), D, D, nM, D / 256, G, c};
        EpiRes<1> E{nullptr, nullptr, a.out, XB, PS2}; pg8::gemm_phase(lds, D, D, D, S, E);
    }
    SEAM(7);
    if (IN(8)) {
        pg8::SchedPlain S{(const char*)XB, (const char*)(ws + WS_W13B), D, D, nM, 2 * FF / 256, G, c};
        EpiSwiglu E{PS2, R1}; pg8::gemm_phase(lds, D, D, D, S, E);
    }
    SEAM(8);
    if (IN(9)) {
        pg8::SchedPlain S{(const char*)R1, (const char*)(ws + WS_W2B), FF, FF, nM, D / 256, G, c};
        EpiRes<2> E{nullptr, nullptr, a.out, XB, nullptr}; pg8::gemm_phase(lds, FF, FF, FF, S, E);
    }
#undef IN
#undef SEAM
}

extern "C" void kernel_launch(void* const* d_in, const int* in_sizes, int n_in, void* d_out, int out_size, void* d_ws, size_t ws_size, hipStream_t stream) {
    static int grid = 0;
    if (grid == 0) {
        if (n_in != 20 || out_size != T * D || ws_size < WS_END) { fprintf(stderr, "kernel_launch: unexpected shapes (n_in %d, out %d, ws %zu < %zu)\n", n_in, out_size, ws_size, (size_t)WS_END); grid = -1; return; }
        int dev = 0, cus = 0, per_cu = 0;
        (void)hipGetDevice(&dev); (void)hipDeviceGetAttribute(&cus, hipDeviceAttributeMultiprocessorCount, dev);
        if (hipFuncSetAttribute((const void*)mk_fwd, hipFuncAttributeMaxDynamicSharedMemorySize, LDS_BYTES) != hipSuccess) { fprintf(stderr, "kernel_launch: hipFuncSetAttribute failed\n"); grid = -1; return; }
        if (hipOccupancyMaxActiveBlocksPerMultiprocessor(&per_cu, (const void*)mk_fwd, NTHREADS, LDS_BYTES) != hipSuccess || per_cu < 1) { fprintf(stderr, "kernel_launch: occupancy query gave %d\n", per_cu); per_cu = 1; }
        (void)hipGetLastError();
        grid = cus;
    }
    if (grid < 0) return;
    Args a{};
    for (int i = 0; i < 20; ++i) a.in[i] = (const float*)d_in[i];
    a.out = (float*)d_out; a.ws = (unsigned char*)d_ws;
#if MK_MULTI_LAUNCH
    for (int ph = 0; ph < NPH; ++ph) { a.ph_lo = ph; a.ph_hi = ph + 1; hipLaunchKernelGGL(mk_fwd, dim3(grid), dim3(NTHREADS), LDS_BYTES, stream, a); }
#else
    a.ph_lo = 0; a.ph_hi = NPH;
    if (hipMemsetAsync((char*)d_ws + WS_BAR, 0, 16384, stream) != hipSuccess) { fprintf(stderr, "kernel_launch: memset of the barrier words failed\n"); return; }
    void* args[] = {&a};
    hipError_t e = hipLaunchCooperativeKernel((const void*)mk_fwd, dim3(grid), dim3(NTHREADS), args, LDS_BYTES, stream);
    if (e != hipSuccess) fprintf(stderr, "cooperative launch failed: %s (grid %d)\n", hipGetErrorString(e), grid);
#endif
}
```

```cpp
#include <hip/hip_runtime.h>
#include <hip/hip_cooperative_groups.h>
#include <cstdio>
#include <cstdint>
namespace cg = cooperative_groups;

#ifndef MK_MULTI_LAUNCH
#define MK_MULTI_LAUNCH 0
#endif

#define LAS __attribute__((address_space(3)))
typedef unsigned short bf16_t;
typedef short bf16x8 __attribute__((ext_vector_type(8)));
typedef float f32x4 __attribute__((ext_vector_type(4)));
typedef unsigned u32x4 __attribute__((ext_vector_type(4)));
typedef unsigned u32x2 __attribute__((ext_vector_type(2)));

constexpr int D = 1024, T_P = 32 * 2048, T_S = 8 * 4096, T = T_P + T_S;
constexpr int FF = 2816, ZC = 2816, GC = 2048, INC = 4880;
constexpr int NPH = 10;
constexpr float EPS = 1e-6f;
constexpr int NTHREADS = 512;
constexpr int LDS_BYTES = 163840;

constexpr size_t al256(size_t x) { return (x + 255) & ~(size_t)255; }
constexpr size_t WS_W13A = 0;
constexpr size_t WS_W2A  = WS_W13A + al256((size_t)2 * FF * D * 2);
constexpr size_t WS_WIN  = WS_W2A + al256((size_t)D * FF * 2);
constexpr size_t WS_WG   = WS_WIN + al256((size_t)4864 * D * 2);
constexpr size_t WS_WPM  = WS_WG + al256((size_t)16 * D * 2);
constexpr size_t WS_WPA  = WS_WPM + al256((size_t)D * 512 * 2);
constexpr size_t WS_WOUT = WS_WPA + al256((size_t)D * 512 * 2);
constexpr size_t WS_W13B = WS_WOUT + al256((size_t)D * D * 2);
constexpr size_t WS_W2B  = WS_W13B + al256((size_t)2 * FF * D * 2);
constexpr size_t WS_ROPE = WS_W2B + al256((size_t)D * FF * 2);
constexpr size_t WS_GATES = WS_ROPE + al256((size_t)4096 * 32 * 8);
constexpr size_t WS_PS0  = WS_GATES + al256((size_t)T * 16 * 4);
constexpr size_t WS_PS1  = WS_PS0 + al256((size_t)T * 4);
constexpr size_t WS_PS2  = WS_PS1 + al256((size_t)T * 4);
constexpr size_t WS_XB   = WS_PS2 + al256((size_t)T * 4);
constexpr size_t WS_R1   = WS_XB + al256((size_t)T * D * 2);
constexpr size_t WS_HFB  = WS_R1 + al256((size_t)T * ZC * 2);
constexpr size_t WS_CTR  = WS_HFB + al256((size_t)T * D * 2);
constexpr size_t WS_BAR  = WS_CTR + 256;
constexpr size_t WS_END  = WS_BAR + 16384;

__device__ __forceinline__ unsigned cvt_pk_bf16(float lo, float hi) { unsigned r; asm("v_cvt_pk_bf16_f32 %0, %1, %2" : "=v"(r) : "v"(lo), "v"(hi)); return r; }
__device__ __forceinline__ unsigned pk2(float lo, float hi) { return cvt_pk_bf16(lo, hi); }
__device__ __forceinline__ unsigned f2bf(float f) { return cvt_pk_bf16(f, 0.f) & 0xffffu; }
__device__ __forceinline__ unsigned f2bf_sw(float f) { unsigned u = __float_as_uint(f); return (u + 0x7fffu + ((u >> 16) & 1u)) >> 16; }
__device__ __forceinline__ unsigned pk2_sw(float lo, float hi) { return f2bf_sw(lo) | (f2bf_sw(hi) << 16); }
__device__ __forceinline__ float bf_lo(unsigned u) { return __uint_as_float(u << 16); }
__device__ __forceinline__ float bf_hi(unsigned u) { return __uint_as_float(u & 0xffff0000u); }
__device__ __forceinline__ float rcpf_(float x) { return __builtin_amdgcn_rcpf(x); }
__device__ __forceinline__ float sigmoidf_(float x) { return rcpf_(1.f + __expf(-x)); }
__device__ __forceinline__ f32x4 mfma16(bf16x8 a, bf16x8 b, f32x4 c) { return __builtin_amdgcn_mfma_f32_16x16x32_bf16(a, b, c, 0, 0, 0); }
#define LDS_WAIT() asm volatile("s_waitcnt lgkmcnt(0)" ::: "memory")

namespace pg8 {
constexpr int BM = 256, BK = 64, HALF = 128, HTB = HALF * BK * 2, STAGE_BYTES = 8 * HTB, NXCD = 8, WGM = 8;
__device__ __forceinline__ int lds_byte(int r, int c) { const int st = (r >> 4) * 2 + (c >> 5), rr = r & 15, cc = c & 31, ob = rr * 64 + cc * 2; return st * 1024 + (ob ^ (((ob >> 9) & 1) << 5)); }
__device__ __forceinline__ void stage_rc(int b, int& R, int& C) { const int st = b / 1024, sb = b % 1024, swz = sb ^ (((sb >> 9) & 1) << 5); R = (st >> 1) * 16 + swz / 64; C = (st & 1) * 32 + (swz % 64) / 2; }
__device__ __forceinline__ int perm32(int rho) { const int n = rho >> 4, i = rho & 15; return 8 * (i >> 2) + 4 * n + (i & 3); }

struct Unit { const char* A; const char* B; int pm, pn, sub; };

__device__ __forceinline__ void tile_of(int L, int nM, int nN, int& pm, int& pn) {
    const int nwg = nM * nN; int wgid = L;
    { const int q = nwg / NXCD, r = nwg % NXCD, xcd = wgid % NXCD, off = wgid / NXCD; wgid = (xcd < r ? xcd * (q + 1) : r * (q + 1) + (xcd - r) * q) + off; }
    const int nig = WGM * nN, gid = wgid / nig, fm = gid * WGM, gsz = (nM - fm) < WGM ? (nM - fm) : WGM;
    pm = fm + ((wgid % nig) % gsz); pn = (wgid % nig) / gsz;
}
struct SchedPlain {
    const char* A; const char* B; int lda, ldb, nM, nN, G, c;
    __device__ __forceinline__ bool next(int i, Unit& u) const {
        const long L = (long)i * G + c; if (L >= (long)nM * nN) return false;
        tile_of((int)L, nM, nN, u.pm, u.pn); u.sub = 0;
        u.A = A + (size_t)u.pm * BM * lda * 2; u.B = B + (size_t)u.pn * BM * ldb * 2; return true;
    }
};
struct SchedPair {
    const char* A0; const char* A1; const char* B0; const char* B1; int lda, ldb, nM, nN, G, c;
    __device__ __forceinline__ bool next(int i, Unit& u) const {
        const long L = (long)(i >> 1) * G + c; if (L >= (long)nM * nN) return false;
        tile_of((int)L, nM, nN, u.pm, u.pn); u.sub = i & 1;
        u.A = (u.sub ? A1 : A0) + (size_t)u.pm * BM * lda * 2; u.B = (u.sub ? B1 : B0) + (size_t)u.pn * BM * ldb * 2; return true;
    }
};

template <class Epi, class Sched>
__device__ __forceinline__ void gemm_phase(LAS unsigned char* lds, const int lda, const int ldb, const int K, const Sched& S, const Epi& E) {
    const int tid = threadIdx.x, wid = __builtin_amdgcn_readfirstlane(tid >> 6), lane = tid & 63, wr = wid >> 2, wc = wid & 3, fr = lane & 15, fq = lane >> 4;
    const int nt = K / BK;
    unsigned voffA[2], voffB[2];
#pragma unroll
    for (int i = 0; i < 2; ++i) { int R, C; stage_rc(tid * 16 + i * 8192, R, C); const int Rb = (R & ~31) + perm32(R & 31);
        voffA[i] = (unsigned)(R * lda + C) * 2u; voffB[i] = (unsigned)(Rb * ldb + C) * 2u; }
    const size_t kstep = (size_t)(BK * 2);
    const size_t hstepA = (size_t)HALF * lda * 2, hstepB = (size_t)HALF * ldb * 2;
    const unsigned ldsw = (unsigned)wid * 1024u;
    const int aoff = lds_byte(wr * 64 + fr, fq * 8), boff = lds_byte(wc * 32 + fr, fq * 8);
#define PG8_SA(b, h) (((b) * 2 + (h)) * HTB)
#define PG8_SB(b, h) ((4 + (b) * 2 + (h)) * HTB)
#define PG8_STAGE(bufoff, gbase, voff) do { _Pragma("unroll") for (int _i = 0; _i < 2; ++_i) \
        __builtin_amdgcn_global_load_lds((const unsigned*)((const char*)(gbase) + (voff)[_i]), (LAS unsigned*)(lds + (bufoff) + ldsw + _i * 8192), 16, 0, 0); } while (0)
#define PG8_LDA(dst, b, h) do { _Pragma("unroll") for (int m = 0; m < 4; ++m) _Pragma("unroll") for (int k = 0; k < 2; ++k) dst[m][k] = *(const LAS bf16x8*)(lds + PG8_SA(b, h) + aoff + m * 2048 + k * 1024); } while (0)
#define PG8_LDB(dst, b, h) do { _Pragma("unroll") for (int n = 0; n < 2; ++n) _Pragma("unroll") for (int k = 0; k < 2; ++k) dst[n][k] = *(const LAS bf16x8*)(lds + PG8_SB(b, h) + boff + n * 2048 + k * 1024); } while (0)
#define PG8_MMA(ai, bj, At, Bt) do { __builtin_amdgcn_s_setprio(1); _Pragma("unroll") for (int m = 0; m < 4; ++m) _Pragma("unroll") for (int n = 0; n < 2; ++n) _Pragma("unroll") for (int k = 0; k < 2; ++k) \
        acc[ai][bj][m][n] = __builtin_amdgcn_mfma_f32_16x16x32_bf16(Bt[n][k], At[m][k], acc[ai][bj][m][n], 0, 0, 0); __builtin_amdgcn_s_setprio(0); } while (0)
#define PG8_WAIT_V(n) asm volatile("s_waitcnt vmcnt(" #n ")" ::: "memory")
#define PG8_WAIT_L(n) asm volatile("s_waitcnt lgkmcnt(" #n ")" ::: "memory")
#define PG8_BAR __builtin_amdgcn_s_barrier()
#define PG8_SCHED __builtin_amdgcn_sched_barrier(0)
    Unit cur, nxt; int ui = 0;
    if (!S.next(0, cur)) return;
    f32x4 acc[2][2][4][2];
#pragma unroll
    for (int a = 0; a < 2; ++a)
#pragma unroll
        for (int b = 0; b < 2; ++b)
#pragma unroll
            for (int m = 0; m < 4; ++m)
#pragma unroll
                for (int n = 0; n < 2; ++n) acc[a][b][m][n] = (f32x4){0.f, 0.f, 0.f, 0.f};
    bf16x8 At[4][2], B0[2][2], B1[2][2];
    float rsv[8];
#pragma unroll
    for (int i = 0; i < 8; ++i) rsv[i] = 0.f;
    const char* cA = cur.A; const char* cB = cur.B;
    PG8_STAGE(PG8_SB(0, 0), cB, voffB); PG8_STAGE(PG8_SB(0, 1), cB + hstepB, voffB); PG8_STAGE(PG8_SA(0, 0), cA, voffA); PG8_STAGE(PG8_SA(0, 1), cA + hstepA, voffA);
    if (wr == 1) PG8_BAR;
    PG8_WAIT_V(2); PG8_BAR;
    PG8_STAGE(PG8_SB(1, 0), cB + kstep, voffB); PG8_STAGE(PG8_SA(1, 0), cA + kstep, voffA); PG8_STAGE(PG8_SB(1, 1), cB + hstepB + kstep, voffB);
    PG8_WAIT_V(6); PG8_BAR;
    for (;;) {
        const bool has_next = S.next(ui + 1, nxt);
        const char* nA = has_next ? nxt.A : cA; const char* nB = has_next ? nxt.B : cB;
        for (int t = 0; t < nt; t += 2) {
            const bool last = (t == nt - 2);
            const char* a1 = cA + (size_t)(t + 1) * kstep;
            const char* a2 = last ? nA : cA + (size_t)(t + 2) * kstep; const char* b2 = last ? nB : cB + (size_t)(t + 2) * kstep;
            const char* a3 = a2 + kstep; const char* b3 = b2 + kstep;
            PG8_LDB(B0, 0, 0); PG8_LDB(B1, 0, 1); PG8_SCHED; PG8_LDA(At, 0, 0); PG8_STAGE(PG8_SA(1, 1), a1 + hstepA, voffA);
            PG8_WAIT_V(8); PG8_WAIT_L(0); PG8_BAR; PG8_MMA(0, 0, At, B0); PG8_MMA(0, 1, At, B1); PG8_BAR; PG8_SCHED;
            PG8_LDA(At, 0, 1); PG8_STAGE(PG8_SB(0, 0), b2, voffB); PG8_STAGE(PG8_SB(0, 1), b2 + hstepB, voffB); PG8_STAGE(PG8_SA(0, 0), a2, voffA);
            PG8_WAIT_V(8); PG8_WAIT_L(0); PG8_BAR; PG8_MMA(1, 0, At, B0); PG8_MMA(1, 1, At, B1); PG8_BAR; PG8_SCHED;
            PG8_LDB(B0, 1, 0); PG8_LDB(B1, 1, 1); PG8_SCHED; PG8_LDA(At, 1, 0); PG8_STAGE(PG8_SA(0, 1), a2 + hstepA, voffA);
            PG8_WAIT_V(8); PG8_WAIT_L(0); PG8_BAR; PG8_MMA(0, 0, At, B0); PG8_MMA(0, 1, At, B1); PG8_BAR; PG8_SCHED;
            PG8_LDA(At, 1, 1); PG8_STAGE(PG8_SB(1, 0), b3, voffB); PG8_STAGE(PG8_SB(1, 1), b3 + hstepB, voffB); PG8_STAGE(PG8_SA(1, 0), a3, voffA);
            PG8_WAIT_V(8); PG8_WAIT_L(0); PG8_BAR;
            if (last) E.pre(cur, wr, fr, rsv);
            PG8_MMA(1, 0, At, B0); PG8_MMA(1, 1, At, B1); PG8_BAR; PG8_SCHED;
        }
        if (wr == 0) PG8_BAR;
        const bool keep = E(acc, cur, wr, wc, fr, fq, rsv);
        if (!has_next) break;
        if (!keep) {
#pragma unroll
            for (int a = 0; a < 2; ++a)
#pragma unroll
                for (int b = 0; b < 2; ++b)
#pragma unroll
                    for (int m = 0; m < 4; ++m)
#pragma unroll
                        for (int n = 0; n < 2; ++n) acc[a][b][m][n] = (f32x4){0.f, 0.f, 0.f, 0.f};
        }
        cur = nxt; cA = nA; cB = nB; ++ui;
        if (wr == 1) PG8_BAR;
    }
    PG8_WAIT_V(0);
    PG8_BAR;
#undef PG8_SA
#undef PG8_SB
#undef PG8_STAGE
#undef PG8_LDA
#undef PG8_LDB
#undef PG8_MMA
#undef PG8_WAIT_V
#undef PG8_WAIT_L
#undef PG8_BAR
#undef PG8_SCHED
}
}

typedef f32x4 AccT[2][2][4][2];

__device__ __forceinline__ float row_rs(const float* ss, int row) { return rsqrtf(ss[row] * (1.f / 1024.f) + EPS); }
__device__ __forceinline__ float silu_mul(float a, float b) { return a * rcpf_(1.f + __expf(-a)) * b; }

struct EpiSwiglu {
    const float* ss; bf16_t* H;
    __device__ __forceinline__ void pre(const pg8::Unit& u, int wr, int fr, float (&rsv)[8]) const {
        const float* p = ss + u.pm * 256 + wr * 64 + fr;
#pragma unroll
        for (int ai = 0; ai < 2; ++ai)
#pragma unroll
            for (int m = 0; m < 4; ++m) rsv[ai * 4 + m] = p[ai * 128 + m * 16];
    }
    __device__ __forceinline__ bool operator()(AccT& acc, const pg8::Unit& u, int wr, int wc, int fr, int fq, const float (&rsv)[8]) const {
        const int row0 = u.pm * 256 + wr * 64 + fr, col0 = u.pn * 128 + wc * 32 + 8 * fq;
#pragma unroll
        for (int ai = 0; ai < 2; ++ai)
#pragma unroll
            for (int m = 0; m < 4; ++m) {
                const int row = row0 + ai * 128 + m * 16; const float r = rsqrtf(rsv[ai * 4 + m] * (1.f / 1024.f) + EPS);
                typedef float f32x2 __attribute__((ext_vector_type(2)));
                const float rn = r * -1.4426950408889634f, r2 = r * r;
                u32x4 w;
#pragma unroll
                for (int n = 0; n < 2; ++n) {
                    const f32x4 gv = acc[ai][0][m][n], uv = acc[ai][1][m][n];
#pragma unroll
                    for (int p = 0; p < 2; ++p) {
                        const f32x2 g2 = {gv[2 * p], gv[2 * p + 1]}, u2 = {uv[2 * p], uv[2 * p + 1]};
                        const f32x2 x2 = g2 * rn; f32x2 e2; e2.x = __builtin_amdgcn_exp2f(x2.x); e2.y = __builtin_amdgcn_exp2f(x2.y);
                        const f32x2 d2 = e2 + 1.0f; f32x2 c2; c2.x = rcpf_(d2.x); c2.y = rcpf_(d2.y);
                        const f32x2 h2 = (g2 * u2) * (c2 * r2);
                        w[2 * n + p] = cvt_pk_bf16(h2.x, h2.y); } }
                *(u32x4*)(H + (size_t)row * FF + col0) = w;
            }
        return false;
    }
};
template <int MODE> struct EpiRes {
    const float* xp; const float* xs; float* out; bf16_t* xb; float* ss;
    __device__ __forceinline__ void pre(const pg8::Unit&, int, int, float (&)[8]) const {}
    __device__ __forceinline__ bool operator()(AccT& acc, const pg8::Unit& u, int wr, int wc, int fr, int fq, const float (&)[8]) const {
        const int row0 = u.pm * 256 + wr * 64 + fr, colt = u.pn * 256 + wc * 32 + 8 * fq;
#pragma unroll
        for (int ai = 0; ai < 2; ++ai) {
            f32x4 xv[4][2][2];
#pragma unroll
            for (int m = 0; m < 4; ++m)
#pragma unroll
                for (int bj = 0; bj < 2; ++bj) {
                    const int row = row0 + ai * 128 + m * 16, col = colt + bj * 128;
                    {   const u32x4 xw = *(const u32x4*)(xb + (size_t)row * D + col);
                        xv[m][bj][0] = (f32x4){bf_lo(xw.x), bf_hi(xw.x), bf_lo(xw.y), bf_hi(xw.y)}; xv[m][bj][1] = (f32x4){bf_lo(xw.z), bf_hi(xw.z), bf_lo(xw.w), bf_hi(xw.w)}; }
                }
#pragma unroll
            for (int m = 0; m < 4; ++m) {
                const int row = row0 + ai * 128 + m * 16; float sq = 0.f;
#pragma unroll
                for (int bj = 0; bj < 2; ++bj) {
                    const int col = colt + bj * 128; const float sc = (MODE == 1) ? 1.f : 0.5f;
                    const f32x4 v0 = xv[m][bj][0] + sc * acc[ai][bj][m][0], v1 = xv[m][bj][1] + sc * acc[ai][bj][m][1];
                    if (MODE == 2) { float* o = out + (size_t)row * D + col; __builtin_nontemporal_store(v0, (f32x4*)o); __builtin_nontemporal_store(v1, (f32x4*)(o + 4)); }
                    if (MODE != 2) {
                        sq += (v0[0] * v0[0] + v0[1] * v0[1]) + (v0[2] * v0[2] + v0[3] * v0[3]) + (v1[0] * v1[0] + v1[1] * v1[1]) + (v1[2] * v1[2] + v1[3] * v1[3]);
                        u32x4 w; w.x = cvt_pk_bf16(v0[0], v0[1]); w.y = cvt_pk_bf16(v0[2], v0[3]); w.z = cvt_pk_bf16(v1[0], v1[1]); w.w = cvt_pk_bf16(v1[2], v1[3]);
                        *(u32x4*)(xb + (size_t)row * D + col) = w; }
                }
                if (MODE != 2) { sq += __shfl_xor(sq, 16); sq += __shfl_xor(sq, 32); if (fq == 0) unsafeAtomicAdd(ss + row, sq); }
            }
        }
        return false;
    }
};
struct EpiIn {
    const float* ss; bf16_t* Z; bf16_t* ZG;
    __device__ __forceinline__ void pre(const pg8::Unit& u, int wr, int fr, float (&rsv)[8]) const {
        const float* p = ss + u.pm * 256 + wr * 64 + fr;
#pragma unroll
        for (int ai = 0; ai < 2; ++ai)
#pragma unroll
            for (int m = 0; m < 4; ++m) rsv[ai * 4 + m] = p[ai * 128 + m * 16];
    }
    __device__ __forceinline__ bool operator()(AccT& acc, const pg8::Unit& u, int wr, int wc, int fr, int fq, const float (&rsv)[8]) const {
        const int row0 = u.pm * 256 + wr * 64 + fr; const bool gate = u.pn >= 11;
        if (!gate) {
            bf16_t* base = Z + u.pn * 256 + wc * 32 + 8 * fq;
#pragma unroll
            for (int ai = 0; ai < 2; ++ai)
#pragma unroll
                for (int m = 0; m < 4; ++m) {
                    const int row = row0 + ai * 128 + m * 16; const float r = rsqrtf(rsv[ai * 4 + m] * (1.f / 1024.f) + EPS);
#pragma unroll
                    for (int bj = 0; bj < 2; ++bj) {
                        const f32x4 v0 = acc[ai][bj][m][0] * r, v1 = acc[ai][bj][m][1] * r;
                        u32x4 w; w.x = cvt_pk_bf16(v0[0], v0[1]); w.y = cvt_pk_bf16(v0[2], v0[3]); w.z = cvt_pk_bf16(v1[0], v1[1]); w.w = cvt_pk_bf16(v1[2], v1[3]);
                        *(u32x4*)(base + (size_t)row * ZC + bj * 128) = w;
                    }
                }
        } else {
            bf16_t* base = ZG + (u.pn - 11) * 128 + wc * 32 + 8 * fq;
#pragma unroll
            for (int ai = 0; ai < 2; ++ai)
#pragma unroll
                for (int m = 0; m < 4; ++m) {
                    const int row = row0 + ai * 128 + m * 16; const float rn = rsqrtf(rsv[ai * 4 + m] * (1.f / 1024.f) + EPS) * -1.4426950408889634f;
                    float rho[8], sga[8];
#pragma unroll
                    for (int n = 0; n < 2; ++n)
#pragma unroll
                        for (int j = 0; j < 4; ++j) {
                            const float em = __builtin_amdgcn_exp2f(fminf(acc[ai][0][m][n][j] * rn, 60.f)), ea = __builtin_amdgcn_exp2f(fminf(acc[ai][1][m][n][j] * rn, 60.f));
                            sga[4 * n + j] = rcpf_(1.f + ea); rho[4 * n + j] = (1.f + ea) * rcpf_(1.f + em); }
                    u32x4 w0, w1;
#pragma unroll
                    for (int k = 0; k < 4; ++k) { w0[k] = cvt_pk_bf16(rho[2 * k], rho[2 * k + 1]); w1[k] = cvt_pk_bf16(sga[2 * k], sga[2 * k + 1]); }
                    *(u32x4*)(base + (size_t)row * GC) = w0; *(u32x4*)(base + (size_t)row * GC + 1024) = w1;
                }
        }
        return false;
    }
};
struct EpiMerge {
    const bf16_t* ZG; bf16_t* MRG;
    __device__ __forceinline__ void pre(const pg8::Unit&, int, int, float (&)[8]) const {}
    __device__ __forceinline__ bool operator()(AccT& acc, const pg8::Unit& u, int wr, int wc, int fr, int fq, const float (&)[8]) const {
        const int row0 = u.pm * 256 + wr * 64 + fr, colt = u.pn * 256 + wc * 32 + 8 * fq;
        const bf16_t* gsrc = ZG + (u.sub ? 1024 : 0) + colt;
#pragma unroll
        for (int ai = 0; ai < 2; ++ai) {
            u32x4 gv[4][2];
#pragma unroll
            for (int m = 0; m < 4; ++m)
#pragma unroll
                for (int bj = 0; bj < 2; ++bj) gv[m][bj] = __builtin_nontemporal_load((const u32x4*)(gsrc + (size_t)(row0 + ai * 128 + m * 16) * GC + bj * 128));
#pragma unroll
            for (int m = 0; m < 4; ++m) {
                const int row = row0 + ai * 128 + m * 16;
#pragma unroll
                for (int bj = 0; bj < 2; ++bj) {
                    const u32x4 gw = gv[m][bj];
                    const f32x4 a0 = (f32x4){bf_lo(gw.x), bf_hi(gw.x), bf_lo(gw.y), bf_hi(gw.y)}, a1 = (f32x4){bf_lo(gw.z), bf_hi(gw.z), bf_lo(gw.w), bf_hi(gw.w)};
                    const f32x4 v0 = acc[ai][bj][m][0] * a0, v1 = acc[ai][bj][m][1] * a1;
                    if (u.sub == 0) { acc[ai][bj][m][0] = v0; acc[ai][bj][m][1] = v1; }
                    else { u32x4 w; w.x = cvt_pk_bf16(v0[0], v0[1]); w.y = cvt_pk_bf16(v0[2], v0[3]); w.z = cvt_pk_bf16(v1[0], v1[1]); w.w = cvt_pk_bf16(v1[2], v1[3]);
                        *(u32x4*)(MRG + (size_t)row * D + colt + bj * 128) = w; }
                }
            }
        }
        return u.sub == 0;
    }
};

__device__ __forceinline__ void tr_item(const float* W, int ldw, int src_col0, int k0, bf16_t* dst, int dpitch, int drow0, const float* gain, float scale, LAS float* scr, int lane) {
    float wv[32];
    const float* wp = W + (size_t)(k0 + (lane >> 5)) * ldw + src_col0 + (lane & 31);
#pragma unroll
    for (int i = 0; i < 32; ++i) wv[i] = wp[(size_t)(2 * i) * ldw];
#pragma unroll
    for (int i = 0; i < 32; ++i) { const int kk = 2 * i + (lane >> 5); const float gv = gain ? gain[k0 + kk] * scale : scale;
        scr[kk * 33 + (lane & 31)] = wv[i] * gv; }
    LDS_WAIT(); asm volatile("" ::: "memory");
    const int c = lane & 7;
#pragma unroll
    for (int j = 0; j < 4; ++j) { const int n = (lane >> 3) + 8 * j; const LAS float* s = scr + (8 * c) * 33 + n;
        u32x4 o; o.x = pk2(s[0 * 33], s[1 * 33]); o.y = pk2(s[2 * 33], s[3 * 33]); o.z = pk2(s[4 * 33], s[5 * 33]); o.w = pk2(s[6 * 33], s[7 * 33]);
        *(u32x4*)(dst + (size_t)(drow0 + n) * dpitch + k0 + 8 * c) = o; }
    LDS_WAIT(); asm volatile("" ::: "memory");
}

struct Args { const float* in[20]; float* out; unsigned char* ws; int ph_lo, ph_hi; };

__device__ __forceinline__ void prep_phase(const Args& a, LAS unsigned char* lds) {
    const int tid = threadIdx.x, lane = tid & 63, wave = __builtin_amdgcn_readfirstlane(tid >> 6);
    const int gw = blockIdx.x * 8 + wave, NGW = gridDim.x * 8;
    LAS float* scr = (LAS float*)(lds + wave * 16384);
    unsigned char* ws = a.ws;
    constexpr int I_W13 = 16 * 88, I_W2 = 44 * 32, I_IN = 16 * 152, I_P = 8 * 32, I_O = 16 * 32;
    constexpr int I_FFN = 2 * I_W13 + I_W2;
    constexpr int NIT = 2 * I_FFN + I_IN + 2 * I_P + I_O;
    for (int it = gw; it < NIT; it += NGW) {
        int r = it;
        if (r < 2 * I_FFN) {
            const int f = r >= I_FFN; if (f) r -= I_FFN;
            const float* nrm = f ? a.in[16] : a.in[2]; const float* w1 = f ? a.in[17] : a.in[3]; const float* w3 = f ? a.in[18] : a.in[4]; const float* w2 = f ? a.in[19] : a.in[5];
            bf16_t* W13 = (bf16_t*)(ws + (f ? WS_W13B : WS_W13A)); bf16_t* W2 = (bf16_t*)(ws + (f ? WS_W2B : WS_W2A));
            if (r < 2 * I_W13) { const int up = r >= I_W13; if (up) r -= I_W13; const int kb = r / 88, nb = r % 88, n = 32 * nb;
                tr_item(up ? w3 : w1, FF, n, 64 * kb, W13, D, 256 * (n >> 7) + (n & 127) + (up ? 128 : 0), nrm, 1.f, scr, lane); }
            else { r -= 2 * I_W13; const int kb = r / 32, nb = r % 32; tr_item(w2, D, 32 * nb, 64 * kb, W2, FF, 32 * nb, nullptr, 1.f, scr, lane); }
            continue;
        }
        r -= 2 * I_FFN;
        if (r < I_IN) { const int kb = r / 152, nb = r % 152, dr = 32 * nb; const int gw_ = dr - 2816;
            const int sc = dr < 2048 ? dr : dr < 2816 ? dr + 16 : (((gw_ >> 7) & 1) ? 3856 : 2832) + 128 * (gw_ >> 8) + (gw_ & 127);
            tr_item(a.in[7], INC, sc, 64 * kb, (bf16_t*)(ws + WS_WIN), D, dr, a.in[6], (dr >= 512 && dr < 1024) ? 0.08838834764831845f : 1.f, scr, lane); continue; }
        r -= I_IN;
        if (r < 2 * I_P) { const int pa = r >= I_P; if (pa) r -= I_P; const int kb = r / 32, nb = r % 32;
            tr_item(pa ? a.in[14] : a.in[13], D, 32 * nb, 64 * kb, (bf16_t*)(ws + (pa ? WS_WPA : WS_WPM)), 512, 32 * nb, nullptr, 1.f, scr, lane); continue; }
        r -= 2 * I_P;
        { const int kb = r / 32, nb = r % 32; tr_item(a.in[15], D, 32 * nb, 64 * kb, (bf16_t*)(ws + WS_WOUT), D, 32 * nb, nullptr, 1.f, scr, lane); }
    }
    const int gt = blockIdx.x * NTHREADS + tid, NGT = gridDim.x * NTHREADS;
    if (gt == 0) *(unsigned*)(ws + WS_CTR) = 0u;
    for (int idx = gt; idx < 16 * D; idx += NGT) { const int g = idx >> 10, k = idx & 1023;
        ((bf16_t*)(ws + WS_WG))[idx] = (bf16_t)f2bf(a.in[7][(size_t)k * INC + 2048 + g] * a.in[6][k]); }
    for (int idx = gt; idx < 4096 * 32; idx += NGT) { const int pos = idx >> 5, i = idx & 31;
        double inv = 1.0; for (int q = 0; q < i; ++q) inv *= 0.74989420933245582730;
        const double ang = (double)pos * inv;
        const double qd = __builtin_rint(ang * 0.63661977236758134308);
        double rr = __builtin_fma(-qd, 1.5707963267948966, ang); rr = __builtin_fma(-qd, 6.123233995736766e-17, rr);
        const double r2 = rr * rr;
        const double sn = rr * (1.0 + r2 * (-1.0 / 6 + r2 * (1.0 / 120 + r2 * (-1.0 / 5040 + r2 * (1.0 / 362880 + r2 * (-1.0 / 39916800 + r2 * (1.0 / 6227020800.0)))))));
        const double cs = 1.0 + r2 * (-0.5 + r2 * (1.0 / 24 + r2 * (-1.0 / 720 + r2 * (1.0 / 40320 + r2 * (-1.0 / 3628800 + r2 * (1.0 / 479001600.0 + r2 * (-1.0 / 87178291200.0)))))));
        const int qn = ((int)qd) & 3;
        const double c = qn == 0 ? cs : qn == 1 ? -sn : qn == 2 ? -cs : sn;
        const double s = qn == 0 ? sn : qn == 1 ? cs : qn == 2 ? -sn : -cs;
        ((float2*)(ws + WS_ROPE))[idx] = make_float2((float)c, (float)s); }
    bf16_t* XB = (bf16_t*)(ws + WS_XB); float* PS0 = (float*)(ws + WS_PS0);
    for (int row0 = gw; row0 < T; row0 += 4 * NGW) {
        f32x4 v[4][4];
#pragma unroll
        for (int r = 0; r < 4; ++r) { const int row = row0 + r * NGW; if (row < T) {
            const float* xr = row < T_P ? a.in[0] + (size_t)row * D : a.in[1] + (size_t)(row - T_P) * D; const f32x4* x4 = (const f32x4*)xr + lane;
#pragma unroll
            for (int j = 0; j < 4; ++j) v[r][j] = __builtin_nontemporal_load(x4 + 64 * j); } }
#pragma unroll
        for (int r = 0; r < 4; ++r) { const int row = row0 + r * NGW; if (row < T) {
            float sq = 0.f;
#pragma unroll
            for (int j = 0; j < 4; ++j) sq += (v[r][j].x * v[r][j].x + v[r][j].y * v[r][j].y) + (v[r][j].z * v[r][j].z + v[r][j].w * v[r][j].w);
#pragma unroll
            for (int o = 1; o < 64; o <<= 1) sq += __shfl_xor(sq, o);
            u32x2* o8 = (u32x2*)(XB + (size_t)row * D) + lane;
#pragma unroll
            for (int j = 0; j < 4; ++j) { u32x2 w; w.x = pk2(v[r][j].x, v[r][j].y); w.y = pk2(v[r][j].z, v[r][j].w); o8[64 * j] = w; }
            if (lane == 0) { PS0[row] = sq; ((float*)(ws + WS_PS1))[row] = 0.f; ((float*)(ws + WS_PS2))[row] = 0.f; } } }
    }
}

__device__ __forceinline__ void gates_phase(const Args& a) {
    const int tid = threadIdx.x, lane = tid & 63, wave = __builtin_amdgcn_readfirstlane(tid >> 6), g = lane >> 4, c16 = lane & 15;
    const int gw = blockIdx.x * 8 + wave, NGW = gridDim.x * 8;
    const bf16_t* XB = (const bf16_t*)(a.ws + WS_XB); const bf16_t* WG = (const bf16_t*)(a.ws + WS_WG);
    const float* PS1 = (const float*)(a.ws + WS_PS1); float* GATES = (float*)(a.ws + WS_GATES);
    const float bias = a.in[8][c16]; const bool isf = (c16 >> 2) & 1;
    for (int it = gw; it < T / 16; it += NGW) {
        const int r0 = it * 16; f32x4 acc = {0.f, 0.f, 0.f, 0.f};
        const bf16_t* ap = XB + (size_t)(r0 + c16) * D + 8 * g; const bf16_t* bp = WG + (size_t)c16 * D + 8 * g;
#pragma unroll 8
        for (int kk = 0; kk < 32; ++kk) { const bf16x8 av = *(const bf16x8*)(ap + 32 * kk); const bf16x8 bv = *(const bf16x8*)(bp + 32 * kk); acc = mfma16(av, bv, acc); }
#pragma unroll
        for (int j = 0; j < 4; ++j) { const int row = r0 + 4 * g + j; float v = acc[j] * row_rs(PS1, row) + bias;
            if (isf) v = fminf(v, 0.f) - log1pf(__expf(-fabsf(v)));
            GATES[(size_t)row * 16 + c16] = v; }
    }
}

typedef short s16x4 __attribute__((ext_vector_type(4)));
#define DPP_F(oldv, src, ctrl, rmask) __int_as_float(__builtin_amdgcn_update_dpp(__float_as_int(oldv), __float_as_int(src), (ctrl), (rmask), 0xf, false))
__device__ __forceinline__ float wave_scan_add(float v) {
    v += DPP_F(0.f, v, 0x111, 0xf); v += DPP_F(0.f, v, 0x112, 0xf); v += DPP_F(0.f, v, 0x114, 0xf); v += DPP_F(0.f, v, 0x118, 0xf);
    v += DPP_F(0.f, v, 0x142, 0xa); v += DPP_F(0.f, v, 0x143, 0xc); return v;
}
__device__ __forceinline__ float wave_scan_max(float v) {
    const float ninf = -3.0e38f;
    v = fmaxf(v, DPP_F(ninf, v, 0x111, 0xf)); v = fmaxf(v, DPP_F(ninf, v, 0x112, 0xf)); v = fmaxf(v, DPP_F(ninf, v, 0x114, 0xf)); v = fmaxf(v, DPP_F(ninf, v, 0x118, 0xf));
    v = fmaxf(v, DPP_F(ninf, v, 0x142, 0xa)); v = fmaxf(v, DPP_F(ninf, v, 0x143, 0xc)); return v;
}
__device__ __forceinline__ float lane63(float v) { return __int_as_float(__builtin_amdgcn_readlane(__float_as_int(v), 63)); }
constexpr int ML_PQ = 272, ML_PV = 304, ML_PW = 144;
constexpr int ML_TSET = 54272;
constexpr int ML_Q = 0, ML_K = 17408, ML_V = 34816, ML_WQ = 2 * ML_TSET, ML_CT = ML_WQ + 9216, ML_SC = ML_CT + 39168, ML_MISC = ML_SC + 3 * 2048;
static_assert(ML_MISC + 256 <= LDS_BYTES, "mLSTM LDS map");
constexpr int SC_ROWS = 0, SC_W2 = 64, SC_SINT = 128, SC_EMT = 192, SC_SOLD = 256;
#define LBAR() asm volatile("s_waitcnt lgkmcnt(0)\n\ts_barrier" ::: "memory")
__device__ __forceinline__ bf16x8 tr_frag(LAS unsigned char* p, int pitch) {
    const s16x4 lo = __builtin_amdgcn_ds_read_tr16_b64_v4i16((LAS s16x4*)p);
    const s16x4 hi = __builtin_amdgcn_ds_read_tr16_b64_v4i16((LAS s16x4*)(p + 4 * pitch));
    return (bf16x8){lo[0], lo[1], lo[2], lo[3], hi[0], hi[1], hi[2], hi[3]};
}
__device__ __forceinline__ void mlstm_chain(LAS unsigned char* lds, const bf16_t* Z, const float* GATES, bf16_t* HOUT, int rowbase, int S, int head, int dir) {
    const int tid = threadIdx.x, lane = tid & 63, wave = __builtin_amdgcn_readfirstlane(tid >> 6), g = lane >> 4, c16 = lane & 15;
    LAS unsigned char* WQ = lds + ML_WQ; LAS unsigned char* CT = lds + ML_CT;
    const int trKo = ML_K + (8 * g + (c16 >> 2)) * ML_PQ + 8 * (lane & 3);
    const int trVo = ML_V + (8 * g + (c16 >> 2)) * ML_PV + 8 * (lane & 3);
    f32x4 st[9];
#pragma unroll
    for (int i = 0; i < 9; ++i) st[i] = (f32x4){0.f, 0.f, 0.f, 0.f};
    float m_prev = -1e30f, gli = 0.f, glf = 0.f;
    for (int i = tid; i < 2 * 64 * 8; i += NTHREADS) { const int ts = i >> 9, r = (i >> 3) & 63, wd = i & 7;
        *(LAS unsigned*)(lds + ts * ML_TSET + ML_V + r * ML_PV + 256 + wd * 4) = wd == 0 ? 0x3F80u : 0u; }
    for (int i = tid; i < 9216 / 16; i += NTHREADS) { const u32x4 z = {0u, 0u, 0u, 0u}; *(LAS u32x4*)(WQ + i * 16) = z; }
    const int NC = S >> 6;
    const bf16_t* zsrc = Z + (size_t)rowbase * ZC + head * 128;
    u32x4 rq[2], rk[2], rv[2];
#define ML_LOAD_TILES(cc) do { const int _oc = dir ? NC - 1 - (cc) : (cc); _Pragma("unroll") for (int i = 0; i < 2; ++i) { const int p = tid + NTHREADS * i, to = p >> 4, cp = p & 15; \
        const bf16_t* src = zsrc + (size_t)(_oc * 64 + to) * ZC + cp * 8; rq[i] = *(const u32x4*)src; rk[i] = *(const u32x4*)(src + 512); rv[i] = *(const u32x4*)(src + 1024); } } while (0)
#define ML_LOAD_GATES(cc) do { const int _oc = dir ? NC - 1 - (cc) : (cc); const int to = dir ? 63 - lane : lane; \
        const float* gp = GATES + (size_t)(rowbase + _oc * 64 + to) * 16 + dir * 8 + head; gli = gp[0]; glf = gp[4]; } while (0)
#define ML_SCAN(scp) do { const float b = wave_scan_add(glf); \
        const float gsum = lane63(b); const float lmb = gli - b; const float pm = wave_scan_max(lmb); \
        const float mloc = gsum + lane63(pm); const float m_new = fmaxf(gsum + m_prev, mloc); \
        const float m_inter = b + m_prev, m_t = fmaxf(b + pm, m_inter); \
        (scp)[SC_ROWS + lane] = __expf(fminf(b - m_t - gsum + m_new, 80.f)); (scp)[SC_W2 + lane] = __expf(gsum + lmb - m_new); \
        (scp)[SC_SINT + lane] = __expf(m_inter - m_t); (scp)[SC_EMT + lane] = __expf(-m_t); \
        if (lane == 0) (scp)[SC_SOLD] = __expf(gsum + m_prev - m_new); \
        m_prev = m_new; } while (0)
#define ML_WRITE_TILES(tset, scp) do { _Pragma("unroll") for (int i = 0; i < 2; ++i) { const int p = tid + NTHREADS * i, to = p >> 4, cp = p & 15; const int tl = dir ? 63 - to : to; \
        const float w2 = (scp)[SC_W2 + tl]; u32x4 kw; \
        _Pragma("unroll") for (int jj = 0; jj < 4; ++jj) kw[jj] = pk2(bf_lo(rk[i][jj]) * w2, bf_hi(rk[i][jj]) * w2); \
        *(LAS u32x4*)((tset) + ML_Q + tl * ML_PQ + cp * 16) = rq[i]; *(LAS u32x4*)((tset) + ML_K + tl * ML_PQ + cp * 16) = kw; *(LAS u32x4*)((tset) + ML_V + tl * ML_PV + cp * 16) = rv[i]; } } while (0)
    ML_LOAD_TILES(0);
    if (wave == 0) { ML_LOAD_GATES(0); ML_SCAN((LAS float*)(lds + ML_SC)); if (NC > 1) ML_LOAD_GATES(1); }
    LBAR();
    ML_WRITE_TILES(lds, (LAS float*)(lds + ML_SC));
    if (NC > 1) { ML_LOAD_TILES(1); if (wave == 0) { ML_SCAN((LAS float*)(lds + ML_SC + 2048)); if (NC > 2) ML_LOAD_GATES(2); } }
    LBAR();
    const int e0 = wave, e1 = wave + 8;
    const int ti0 = e0 >= 6 ? 3 : e0 >= 3 ? 2 : e0 >= 1 ? 1 : 0, si0 = e0 - ti0 * (ti0 + 1) / 2;
    const int ti1 = 3, si1 = e1 - 6;
    int sci = 0;
    for (int c = 0; c < NC; ++c) {
        const int oc = dir ? NC - 1 - c : c; const int crow0 = rowbase + oc * 64;
        LAS unsigned char* tset = lds + (c & 1) * ML_TSET;
        LAS unsigned char* Qs = tset + ML_Q; LAS unsigned char* Ks = tset + ML_K;
        LAS unsigned char* trK = tset + trKo; LAS unsigned char* trV = tset + trVo;
        LAS float* sc = (LAS float*)(lds + ML_SC + sci * 2048);
        const int sc1 = sci == 2 ? 0 : sci + 1, sc2 = sc1 == 2 ? 0 : sc1 + 1;
#pragma unroll
        for (int vt = 0; vt < 9; ++vt) { u32x2 w; w.x = pk2(st[vt][0], st[vt][1]); w.y = pk2(st[vt][2], st[vt][3]);
            *(LAS u32x2*)(CT + (16 * vt + c16) * ML_PQ + (16 * wave + 4 * g) * 2) = w; }
        {
            const int nq = wave < 2 ? 2 : 1;
            bf16x8 sa[2][4], sb[2][4];
#pragma unroll
            for (int q = 0; q < 2; ++q) { if (q < nq) { const int ti = q ? ti1 : ti0, si = q ? si1 : si0;
#pragma unroll
                for (int kk = 0; kk < 4; ++kk) { sa[q][kk] = *(const LAS bf16x8*)(Ks + (16 * si + c16) * ML_PQ + (32 * kk + 8 * g) * 2);
                    sb[q][kk] = *(const LAS bf16x8*)(Qs + (16 * ti + c16) * ML_PQ + (32 * kk + 8 * g) * 2); } } }
            __builtin_amdgcn_sched_barrier(0);
#pragma unroll
            for (int q = 0; q < 2; ++q) { if (q < nq) { const int ti = q ? ti1 : ti0, si = q ? si1 : si0;
                f32x4 acc = {0.f, 0.f, 0.f, 0.f};
#pragma unroll
                for (int kk = 0; kk < 4; ++kk) acc = mfma16(sa[q][kk], sb[q][kk], acc);
                const int t = 16 * ti + c16, s0 = 16 * si + 4 * g; const float rsc = sc[SC_ROWS + t];
                u32x2 w; w.x = pk2(s0 <= t ? rsc * acc[0] : 0.f, s0 + 1 <= t ? rsc * acc[1] : 0.f); w.y = pk2(s0 + 2 <= t ? rsc * acc[2] : 0.f, s0 + 3 <= t ? rsc * acc[3] : 0.f);
                *(LAS u32x2*)(WQ + t * ML_PW + s0 * 2) = w; } }
        }
        {
            const float s_old = sc[SC_SOLD];
            bf16x8 ak[2];
#pragma unroll
            for (int kk = 0; kk < 2; ++kk) ak[kk] = tr_frag(trK + (32 * kk) * ML_PQ + (16 * wave) * 2, ML_PQ);
#pragma unroll
            for (int hb = 0; hb < 2; ++hb) {
                bf16x8 bvv[5][2];
#pragma unroll
                for (int v5 = 0; v5 < 5; ++v5) { const int vt = hb * 5 + v5; if (vt < 9) {
#pragma unroll
                    for (int kk = 0; kk < 2; ++kk) bvv[v5][kk] = tr_frag(trV + (32 * kk) * ML_PV + (16 * vt) * 2, ML_PV); } }
                __builtin_amdgcn_sched_barrier(0);
#pragma unroll
                for (int v5 = 0; v5 < 5; ++v5) { const int vt = hb * 5 + v5; if (vt < 9) { st[vt] = st[vt] * s_old;
#pragma unroll
                    for (int kk = 0; kk < 2; ++kk) st[vt] = mfma16(ak[kk], bvv[v5][kk], st[vt]); } }
                __builtin_amdgcn_sched_barrier(0);
            }
        }
        LBAR();
        {
            const int tt = wave & 3, vh = wave >> 2;
            bf16x8 aw[2], aq[4];
#pragma unroll
            for (int kk = 0; kk < 2; ++kk) aw[kk] = *(const LAS bf16x8*)(WQ + (16 * tt + c16) * ML_PW + (32 * kk + 8 * g) * 2);
#pragma unroll
            for (int kk = 0; kk < 4; ++kk) aq[kk] = *(const LAS bf16x8*)(Qs + (16 * tt + c16) * ML_PQ + (32 * kk + 8 * g) * 2);
            const int t = 16 * tt + c16; const float sint = sc[SC_SINT + t], emt = sc[SC_EMT + t];
            f32x4 tot[5];
#pragma unroll
            for (int hb = 0; hb < 3; ++hb) {
                bf16x8 fv[2][2], fc[2][4];
#pragma unroll
                for (int q3 = 0; q3 < 2; ++q3) { const int q = hb * 2 + q3; if (q < 5) { const int vt = (q == 4) ? 8 : 4 * vh + q;
#pragma unroll
                    for (int kk = 0; kk < 2; ++kk) fv[q3][kk] = tr_frag(trV + (32 * kk) * ML_PV + (16 * vt) * 2, ML_PV);
#pragma unroll
                    for (int kk = 0; kk < 4; ++kk) fc[q3][kk] = *(const LAS bf16x8*)(CT + (16 * vt + c16) * ML_PQ + (32 * kk + 8 * g) * 2); } }
                __builtin_amdgcn_sched_barrier(0);
#pragma unroll
                for (int q3 = 0; q3 < 2; ++q3) { const int q = hb * 2 + q3; if (q < 5) { f32x4 ai = {0.f, 0.f, 0.f, 0.f}, ax = {0.f, 0.f, 0.f, 0.f};
#pragma unroll
                    for (int kk = 0; kk < 2; ++kk) ai = mfma16(fv[q3][kk], aw[kk], ai);
#pragma unroll
                    for (int kk = 0; kk < 4; ++kk) ax = mfma16(fc[q3][kk], aq[kk], ax);
                    tot[q] = ai + sint * ax; } }
                __builtin_amdgcn_sched_barrier(0);
            }
            const float den = __shfl(tot[4][0], c16);
            const float inv = rcpf_(fmaxf(fabsf(den), emt));
            const int to = dir ? 63 - t : t;
            bf16_t* hp = HOUT + (size_t)(crow0 + to) * 512 + head * 128 + 4 * g;
#pragma unroll
            for (int q = 0; q < 4; ++q) { const int vt = 4 * vh + q; u32x2 w; w.x = pk2(tot[q][0] * inv, tot[q][1] * inv); w.y = pk2(tot[q][2] * inv, tot[q][3] * inv);
                *(u32x2*)(hp + 16 * vt) = w; }
        }
        if (c + 1 < NC) ML_WRITE_TILES(lds + ((c + 1) & 1) * ML_TSET, (LAS float*)(lds + ML_SC + sc1 * 2048));
        if (c + 2 < NC) { ML_LOAD_TILES(c + 2); if (wave == 0) { ML_SCAN((LAS float*)(lds + ML_SC + sc2 * 2048)); if (c + 3 < NC) ML_LOAD_GATES(c + 3); } }
        sci = sc1;
        LBAR();
    }
#undef ML_LOAD_TILES
#undef ML_LOAD_GATES
#undef ML_SCAN
#undef ML_WRITE_TILES
}

constexpr int AT_PK = 144, AT_K = 0, AT_V = 384 * AT_PK;
__device__ __forceinline__ void attn_item(LAS unsigned char* lds, bf16_t* Z, const float2* ROPE, const float* q_norm, const float* k_norm, const float* sink, int it) {
    const int tid = threadIdx.x, lane = tid & 63, wave = __builtin_amdgcn_readfirstlane(tid >> 6), g = lane >> 4, c16 = lane & 15;
    const int bg = it >> 1, kvh = it & 1, row0 = bg * 128;
    int pos0, S; if (row0 < T_P) { pos0 = row0 & 2047; S = 2048; } else { pos0 = (row0 - T_P) & 4095; S = 4096; }
    LAS unsigned char* Ks = lds + AT_K; LAS unsigned char* Vs = lds + AT_V;
    const int hq = kvh * 4 + (wave >> 1); const float snk = sink[hq];
    const int ko = tid & 3, kj0 = tid >> 2, vo = tid & 7, vj0 = tid >> 3;
    u32x4 klo[3], khi[3], vv[6];
#pragma unroll
    for (int i = 0; i < 6; ++i) { const int kj = vj0 + 64 * i, pos = pos0 - 128 + kj; const bool valid = pos >= 0 && pos < S;
        vv[i] = (u32x4){0u, 0u, 0u, 0u};
        if (valid) vv[i] = *(const u32x4*)(Z + (size_t)(row0 - 128 + kj) * ZC + 2688 + kvh * 64 + 8 * vo); }
    u32x4 qf0[4], qf1[4];
    {
        float qn1[8], qn2[8];
#pragma unroll
        for (int j = 0; j < 8; ++j) { qn1[j] = q_norm[8 * g + j]; qn2[j] = q_norm[32 + 8 * g + j]; }
        u32x4 qlo[4], qhi[4]; f32x4 qr[4][4];
#pragma unroll
        for (int qt = 0; qt < 4; ++qt) { const int qi = (wave & 1) * 64 + 16 * qt + c16; const bf16_t* qptr = Z + (size_t)(row0 + qi) * ZC + 2048 + hq * 64;
            qlo[qt] = *(const u32x4*)(qptr + 8 * g); qhi[qt] = *(const u32x4*)(qptr + 32 + 8 * g);
        }
#pragma unroll
        for (int qt = 0; qt < 4; ++qt) {
            if ((qt & 1) == 0) {
#pragma unroll
                for (int q2 = 0; q2 < 2; ++q2) { const int qi2 = (wave & 1) * 64 + 16 * (qt + q2) + c16; const f32x4* rp = (const f32x4*)(ROPE + (size_t)(pos0 + qi2) * 32 + 8 * g);
#pragma unroll
                    for (int k = 0; k < 4; ++k) qr[qt + q2][k] = rp[k]; } }
            float x1[8], x2[8];
#pragma unroll
            for (int jj = 0; jj < 4; ++jj) { x1[2 * jj] = bf_lo(qlo[qt][jj]); x1[2 * jj + 1] = bf_hi(qlo[qt][jj]); x2[2 * jj] = bf_lo(qhi[qt][jj]); x2[2 * jj + 1] = bf_hi(qhi[qt][jj]); }
            float ss = 0.f;
#pragma unroll
            for (int j = 0; j < 8; ++j) ss += x1[j] * x1[j] + x2[j] * x2[j];
            ss += __shfl_xor(ss, 16); ss += __shfl_xor(ss, 32);
            const float rs = rsqrtf(ss * (1.f / 64.f) + EPS) * (0.125f * 1.4426950408889634f);
            float y1[8], y2[8];
#pragma unroll
            for (int j = 0; j < 8; ++j) { const float av = x1[j] * rs * qn1[j], bv = x2[j] * rs * qn2[j]; const float cs = qr[qt][j >> 1][(j & 1) * 2], sn = qr[qt][j >> 1][(j & 1) * 2 + 1];
                y1[j] = av * cs - bv * sn; y2[j] = bv * cs + av * sn; }
#pragma unroll
            for (int jj = 0; jj < 4; ++jj) { qf0[qt][jj] = pk2(y1[2 * jj], y1[2 * jj + 1]); qf1[qt][jj] = pk2(y2[2 * jj], y2[2 * jj + 1]); }
        }
    }
    {
#pragma unroll
    for (int i = 0; i < 3; ++i) { const int kj = kj0 + 128 * i, pos = pos0 - 128 + kj; const bool valid = pos >= 0 && pos < S;
        klo[i] = (u32x4){0u, 0u, 0u, 0u}; khi[i] = klo[i];
        if (valid) { const bf16_t* src = Z + (size_t)(row0 - 128 + kj) * ZC + 2560 + kvh * 64 + 8 * ko; klo[i] = *(const u32x4*)src; khi[i] = *(const u32x4*)(src + 32); } }
        float kn1[8], kn2[8];
#pragma unroll
        for (int j = 0; j < 8; ++j) { kn1[j] = k_norm[8 * ko + j]; kn2[j] = k_norm[32 + 8 * ko + j]; }
        f32x4 kr[3][4];
#pragma unroll
        for (int i = 0; i < 3; ++i) { const int kj = kj0 + 128 * i, pos = pos0 - 128 + kj; const int pc = (pos >= 0 && pos < S) ? pos : 0;
            const f32x4* rp = (const f32x4*)(ROPE + (size_t)pc * 32 + 8 * ko);
#pragma unroll
            for (int k = 0; k < 4; ++k) kr[i][k] = rp[k]; }
#pragma unroll
        for (int i = 0; i < 3; ++i) { const int kj = kj0 + 128 * i;
            float x1[8], x2[8];
#pragma unroll
            for (int jj = 0; jj < 4; ++jj) { x1[2 * jj] = bf_lo(klo[i][jj]); x1[2 * jj + 1] = bf_hi(klo[i][jj]); x2[2 * jj] = bf_lo(khi[i][jj]); x2[2 * jj + 1] = bf_hi(khi[i][jj]); }
            float ss = 0.f;
#pragma unroll
            for (int j = 0; j < 8; ++j) ss += x1[j] * x1[j] + x2[j] * x2[j];
            ss += __shfl_xor(ss, 1); ss += __shfl_xor(ss, 2);
            const float rs = rsqrtf(ss * (1.f / 64.f) + EPS);
            float y1[8], y2[8];
#pragma unroll
            for (int j = 0; j < 8; ++j) { const float av = x1[j] * rs * kn1[j], bv = x2[j] * rs * kn2[j]; const float cs = kr[i][j >> 1][(j & 1) * 2], sn = kr[i][j >> 1][(j & 1) * 2 + 1];
                y1[j] = av * cs - bv * sn; y2[j] = bv * cs + av * sn; }
            u32x4 w1, w2;
#pragma unroll
            for (int jj = 0; jj < 4; ++jj) { w1[jj] = pk2(y1[2 * jj], y1[2 * jj + 1]); w2[jj] = pk2(y2[2 * jj], y2[2 * jj + 1]); }
            *(LAS u32x4*)(Ks + kj * AT_PK + 16 * ko) = w1; *(LAS u32x4*)(Ks + kj * AT_PK + 64 + 16 * ko) = w2; }
#pragma unroll
        for (int i = 0; i < 6; ++i) *(LAS u32x4*)(Vs + (vj0 + 64 * i) * AT_PK + 16 * vo) = vv[i];
    }
    __syncthreads();
    LAS unsigned char* trP = Vs + (4 * g + (c16 >> 2)) * AT_PK + 8 * (lane & 3);
#pragma unroll 1
    for (int qt = 0; qt < 4; ++qt) {
        const int q0 = (wave & 1) * 64 + 16 * qt, qi = q0 + c16;
        const bf16x8 qa = __builtin_bit_cast(bf16x8, qf0[0]), qb = __builtin_bit_cast(bf16x8, qf1[0]);
        const int ks0 = q0 & ~31;
        f32x4 s[18]; float mx = -1e30f;
        const float snk2 = snk * 1.4426950408889634f;
#pragma unroll
        for (int i = 0; i < 18; ++i) { const int kb = ks0 + 16 * i;
            const int kp0 = pos0 - 128 + kb; const bool dead = kb < q0 || kb > q0 + 256 || kp0 < 0 || kp0 >= S;
            f32x4 acc = {-1e30f, -1e30f, -1e30f, -1e30f};
            if (!dead) {
                const bf16x8 a0 = *(const LAS bf16x8*)(Ks + (kb + c16) * AT_PK + 16 * g), a1 = *(const LAS bf16x8*)(Ks + (kb + c16) * AT_PK + 64 + 16 * g);
                acc = (f32x4){0.f, 0.f, 0.f, 0.f}; acc = mfma16(a0, qa, acc); acc = mfma16(a1, qb, acc);
                if (kb == q0) {
#pragma unroll
                    for (int j = 0; j < 4; ++j) acc[j] = (4 * g + j >= c16) ? acc[j] : -1e30f; }
                if (kb == q0 + 256) {
#pragma unroll
                    for (int j = 0; j < 4; ++j) acc[j] = (4 * g + j <= c16) ? acc[j] : -1e30f; }
                mx = fmaxf(mx, fmaxf(fmaxf(acc[0], acc[1]), fmaxf(acc[2], acc[3])));
            }
            s[i] = acc; }
        mx = fmaxf(mx, __shfl_xor(mx, 16)); mx = fmaxf(mx, __shfl_xor(mx, 32)); mx = fmaxf(mx, snk2);
        float sum = 0.f;
#pragma unroll
        for (int i = 0; i < 18; ++i) { const int kb = ks0 + 16 * i; const int kp0 = pos0 - 128 + kb; const bool dead = kb < q0 || kb > q0 + 256 || kp0 < 0 || kp0 >= S;
            if (!dead) {
#pragma unroll
                for (int j = 0; j < 4; ++j) { const float p = __builtin_amdgcn_exp2f(s[i][j] - mx); s[i][j] = p; sum += p; } }
            else s[i] = (f32x4){0.f, 0.f, 0.f, 0.f}; }
        sum += __shfl_xor(sum, 16); sum += __shfl_xor(sum, 32);
        const float inv = rcpf_(sum + __builtin_amdgcn_exp2f(snk2 - mx));
        f32x4 o[4];
#pragma unroll
        for (int dt = 0; dt < 4; ++dt) o[dt] = (f32x4){0.f, 0.f, 0.f, 0.f};
#pragma unroll
        for (int kk = 0; kk < 9; ++kk) {
            u32x4 pw; pw.x = pk2(s[2 * kk][0] * inv, s[2 * kk][1] * inv); pw.y = pk2(s[2 * kk][2] * inv, s[2 * kk][3] * inv);
            pw.z = pk2(s[2 * kk + 1][0] * inv, s[2 * kk + 1][1] * inv); pw.w = pk2(s[2 * kk + 1][2] * inv, s[2 * kk + 1][3] * inv);
            const bf16x8 pb = __builtin_bit_cast(bf16x8, pw);
#pragma unroll
            for (int dt = 0; dt < 4; ++dt) { LAS unsigned char* vp = trP + (ks0 + 32 * kk) * AT_PK + (16 * dt) * 2;
                const s16x4 v0 = __builtin_amdgcn_ds_read_tr16_b64_v4i16((LAS s16x4*)vp), v1 = __builtin_amdgcn_ds_read_tr16_b64_v4i16((LAS s16x4*)(vp + 16 * AT_PK));
                const bf16x8 av = (bf16x8){v0[0], v0[1], v0[2], v0[3], v1[0], v1[1], v1[2], v1[3]};
                o[dt] = mfma16(av, pb, o[dt]); }
        }
        bf16_t* qptr = Z + (size_t)(row0 + qi) * ZC + 2048 + hq * 64;
#pragma unroll
        for (int dt = 0; dt < 4; ++dt) { u32x2 w; w.x = pk2_sw(o[dt][0], o[dt][1]); w.y = pk2_sw(o[dt][2], o[dt][3]); *(u32x2*)(qptr + 16 * dt + 4 * g) = w; }
        qf0[0] = qf0[1]; qf0[1] = qf0[2]; qf0[2] = qf0[3]; qf1[0] = qf1[1]; qf1[1] = qf1[2]; qf1[2] = qf1[3];
    }
    __syncthreads();
}

__device__ __forceinline__ void mix_phase(const Args& a, LAS unsigned char* lds) {
    bf16_t* Z = (bf16_t*)(a.ws + WS_R1); const float* GATES = (const float*)(a.ws + WS_GATES); bf16_t* HFB = (bf16_t*)(a.ws + WS_HFB);
    for (int it = blockIdx.x; it < 320; it += gridDim.x) {
        int rowbase, S, head, dir;
        if (it >= 64 && it < 128) { const int c2 = it - 64; const int sq = c2 >> 3; head = (c2 >> 1) & 3; dir = c2 & 1; rowbase = T_P + sq * 4096; S = 4096; }
        else { const int c2 = it < 64 ? it : it - 64; const int sq = c2 >> 3; head = (c2 >> 1) & 3; dir = c2 & 1; rowbase = sq * 2048; S = 2048; }
        mlstm_chain(lds, Z, GATES, HFB + (size_t)dir * T * 512, rowbase, S, head, dir);
    }
    unsigned* ctr = (unsigned*)(a.ws + WS_CTR);
    volatile LAS int* slot = (volatile LAS int*)(lds + ML_MISC);
    for (;;) {
        __syncthreads();
        if (threadIdx.x == 0) *slot = (int)atomicAdd(ctr, 1u);
        __syncthreads();
        const int it = *slot;
        if (it >= 1536) break;
        attn_item(lds, Z, (const float2*)(a.ws + WS_ROPE), a.in[10], a.in[11], a.in[12], it);
    }
}

__device__ __forceinline__ void norm_phase(const Args& a) {
    const int tid = threadIdx.x, lane = tid & 63, wave = __builtin_amdgcn_readfirstlane(tid >> 6);
    const int gw = blockIdx.x * 8 + wave, NGW = gridDim.x * 8;
    bf16_t* Z = (bf16_t*)(a.ws + WS_R1); const bf16_t* HF = (const bf16_t*)(a.ws + WS_HFB); const bf16_t* HB = HF + (size_t)T * 512;
    const float* mn = a.in[9] + 8 * lane; float mnv[8];
#pragma unroll
    for (int j = 0; j < 8; ++j) mnv[j] = mn[j];
    for (int row0 = gw; row0 < T; row0 += 4 * NGW) {
        u32x4 f[4], b[4], mo[4];
#pragma unroll
        for (int r = 0; r < 4; ++r) { const int row = row0 + r * NGW; if (row < T) {
            f[r] = __builtin_nontemporal_load((const u32x4*)(HF + (size_t)row * 512 + 8 * lane)); b[r] = __builtin_nontemporal_load((const u32x4*)(HB + (size_t)row * 512 + 8 * lane)); mo[r] = __builtin_nontemporal_load((const u32x4*)(Z + (size_t)row * ZC + 1536 + 8 * lane)); } }
#pragma unroll
        for (int r = 0; r < 4; ++r) { const int row = row0 + r * NGW; if (row < T) {
            float h[8], ss = 0.f;
#pragma unroll
            for (int jj = 0; jj < 4; ++jj) { h[2 * jj] = bf_lo(f[r][jj]) + bf_lo(b[r][jj]); h[2 * jj + 1] = bf_hi(f[r][jj]) + bf_hi(b[r][jj]); }
#pragma unroll
            for (int j = 0; j < 8; ++j) ss += h[j] * h[j];
            ss += __shfl_xor(ss, 1); ss += __shfl_xor(ss, 2); ss += __shfl_xor(ss, 4); ss += __shfl_xor(ss, 8);
            const float rs = rsqrtf(ss * (1.f / 128.f) + EPS);
            u32x4 w;
#pragma unroll
            for (int jj = 0; jj < 4; ++jj) w[jj] = pk2(h[2 * jj] * rs * mnv[2 * jj] * sigmoidf_(bf_lo(mo[r][jj])), h[2 * jj + 1] * rs * mnv[2 * jj + 1] * sigmoidf_(bf_hi(mo[r][jj])));
            *(u32x4*)(Z + (size_t)row * ZC + 1536 + 8 * lane) = w; } }
    }
}

#define XB_TMO      128
#define XB_XCNT(j)  (256  + 64 * (j))
#define XB_XSUB(j)  (1280 + 64 * (j))
#define XB_XGEN(j)  (2304 + 64 * (j))
#define XB_TOP      3328
#define XB_TOPGEN   3392
#define XCD_BAR_WORDS 3456
#define XB_SPIN_CAP (1u << 18)
__device__ __forceinline__ unsigned xb_ld(unsigned* p)              { return __hip_atomic_load(p, __ATOMIC_RELAXED, __HIP_MEMORY_SCOPE_AGENT); }
__device__ __forceinline__ unsigned xb_add(unsigned* p, unsigned v) { return __hip_atomic_fetch_add(p, v, __ATOMIC_RELAXED, __HIP_MEMORY_SCOPE_AGENT); }
__device__ __forceinline__ unsigned xb_xcc_id() { return (unsigned)__builtin_amdgcn_s_getreg((3 << 11) | 20) & 0xFu; }
#define XB_SPIN(cond, bar) do { unsigned _sp = 0; while (cond) { __builtin_amdgcn_s_sleep(1); \
    if ((++_sp & 255u) == 0u) { if (xb_ld(&(bar)[XB_TMO])) break; if (_sp > XB_SPIN_CAP) { atomicAdd(&(bar)[XB_TMO], 1u); break; } } } } while (0)
struct XcdBarrier { unsigned* bar; unsigned x; volatile LAS unsigned* st; };
__device__ __forceinline__ XcdBarrier xcd_barrier_post(unsigned* bar, volatile LAS unsigned* st) {
    XcdBarrier b; b.bar = bar; b.x = xb_xcc_id(); b.st = st;
    if (threadIdx.x == 0) (void)xb_add(&bar[XB_XCNT(b.x)], 1u);
    return b;
}
__device__ __forceinline__ void xcd_barrier_complete(unsigned* bar, unsigned x, unsigned& nloc, unsigned& nx) {
    const unsigned G = gridDim.x * gridDim.y * gridDim.z;
    unsigned sum, cnt, mine, sp = 0u;
    for (;;) {
        sum = 0u; cnt = 0u; mine = 0u;
#pragma unroll
        for (unsigned j = 0; j < 16; ++j) { const unsigned c = xb_ld(&bar[XB_XCNT(j)]); sum += c; cnt += (c > 0u) ? 1u : 0u; mine = (j == x) ? c : mine; }
        if (sum == G) break;
        __builtin_amdgcn_s_sleep(1);
        if ((++sp & 255u) == 0u) { if (xb_ld(&bar[XB_TMO])) break; if (sp > XB_SPIN_CAP) { atomicAdd(&bar[XB_TMO], 1u); break; } }
    }
    nloc = mine > 0u ? mine : 1u; nx = cnt > 0u ? cnt : 1u;
}
__device__ __forceinline__ void xcd_barrier(const XcdBarrier& b) {
    asm volatile("s_waitcnt vmcnt(0)" ::: "memory");
    __syncthreads();
    if (threadIdx.x == 0) {
        unsigned* bar = b.bar;
        __builtin_amdgcn_s_waitcnt(0);
        unsigned nloc = b.st[0], nx = b.st[1];
        if (nloc == 0u) { xcd_barrier_complete(bar, b.x, nloc, nx); b.st[0] = nloc; b.st[1] = nx; }
        const unsigned old = xb_add(&bar[XB_XSUB(b.x)], 1u);
        const unsigned gen = old / nloc;
        if (old + 1u == (gen + 1u) * nloc) {
            __builtin_amdgcn_fence(__ATOMIC_RELEASE, "agent");
            asm volatile("s_waitcnt vmcnt(0)" ::: "memory");
            const unsigned og = xb_add(&bar[XB_TOP], 1u);
            const unsigned tg = og / nx;
            if (og + 1u == (tg + 1u) * nx) xb_add(&bar[XB_TOPGEN], 1u);
            else XB_SPIN(xb_ld(&bar[XB_TOPGEN]) == tg, bar);
            __builtin_amdgcn_fence(__ATOMIC_ACQUIRE, "agent");
            xb_add(&bar[XB_XGEN(b.x)], 1u);
            asm volatile("s_waitcnt vmcnt(0)" ::: "memory");
        } else {
            XB_SPIN(xb_ld(&bar[XB_XGEN(b.x)]) == gen, bar);
            __builtin_amdgcn_fence(__ATOMIC_ACQUIRE, "agent");
            asm volatile("s_waitcnt vmcnt(0)" ::: "memory");
        }
    }
    __syncthreads();
}

__global__ void __launch_bounds__(NTHREADS, 2) mk_fwd(Args a) {
    extern __shared__ __attribute__((aligned(16))) unsigned char lds_raw[];
    LAS unsigned char* lds = (LAS unsigned char*)lds_raw;
    cg::grid_group grid = cg::this_grid();
    const int lo = a.ph_lo, hi = a.ph_hi, G = gridDim.x, c = blockIdx.x;
    unsigned char* ws = a.ws;
    bf16_t* XB = (bf16_t*)(ws + WS_XB); bf16_t* R1 = (bf16_t*)(ws + WS_R1); bf16_t* MRG = (bf16_t*)(ws + WS_HFB); bf16_t* ZG = (bf16_t*)a.out;
    float* PS0 = (float*)(ws + WS_PS0); float* PS1 = (float*)(ws + WS_PS1); float* PS2 = (float*)(ws + WS_PS2);
    constexpr int nM = T / 256;
#define IN(k) (lo <= (k) && (k) < hi)
#define SEAM(k) do { if (IN(k) && IN((k) + 1)) { if (lo < 0) grid.sync(); else xcd_barrier(xbar); } } while (0)
    volatile LAS unsigned* xst = (volatile LAS unsigned*)(lds + LDS_BYTES - 64);
    if (threadIdx.x < 2) xst[threadIdx.x] = 0u;
    __syncthreads();
    XcdBarrier xbar; xbar.bar = (unsigned*)(ws + WS_BAR); xbar.x = 0; xbar.st = xst;
    if (hi - lo > 1) xbar = xcd_barrier_post((unsigned*)(ws + WS_BAR), xst);
    if (IN(0)) { prep_phase(a, lds); __syncthreads(); }
    SEAM(0);
    if (IN(1)) {
        pg8::SchedPlain S{(const char*)XB, (const char*)(ws + WS_W13A), D, D, nM, 2 * FF / 256, G, c};
        EpiSwiglu E{PS0, R1}; pg8::gemm_phase(lds, D, D, D, S, E);
    }
    SEAM(1);
    if (IN(2)) {
        pg8::SchedPlain S{(const char*)R1, (const char*)(ws + WS_W2A), FF, FF, nM, D / 256, G, c};
        EpiRes<0> E{a.in[0], a.in[1], a.out, XB, PS1}; pg8::gemm_phase(lds, FF, FF, FF, S, E);
    }
    SEAM(2);
    if (IN(3)) {
        pg8::SchedPlain S{(const char*)XB, (const char*)(ws + WS_WIN), D, D, nM, 19, G, c};
        EpiIn E{PS1, R1, ZG}; pg8::gemm_phase(lds, D, D, D, S, E);
        gates_phase(a);
    }
    SEAM(3);
    if (IN(4)) mix_phase(a, lds);
    SEAM(4);
    if (IN(5)) norm_phase(a);
    SEAM(5);
    if (IN(6)) {
        pg8::SchedPair S{(const char*)(R1 + 1536), (const char*)(R1 + 2048), (const char*)(ws + WS_WPM), (const char*)(ws + WS_WPA), ZC, 512, nM, D / 256, G, c};
        EpiMerge E{ZG, MRG}; pg8::gemm_phase(lds, ZC, 512, 512, S, E);
    }
    SEAM(6);
    if (IN(7)) {
        pg8::SchedPlain S{(const char*)MRG, (const char*)(ws + WS_WOUT), D, D, nM, D / 256, G, c};
        EpiRes<1> E{nullptr, nullptr, a.out, XB, PS2}; pg8::gemm_phase(lds, D, D, D, S, E);
    }
    SEAM(7);
    if (IN(8)) {
        pg8::SchedPlain S{(const char*)XB, (const char*)(ws + WS_W13B), D, D, nM, 2 * FF / 256, G, c};
        EpiSwiglu E{PS2, R1}; pg8::gemm_phase(lds, D, D, D, S, E);
    }
    SEAM(8);
    if (IN(9)) {
        pg8::SchedPlain S{(const char*)R1, (const char*)(ws + WS_W2B), FF, FF, nM, D / 256, G, c};
        EpiRes<2> E{nullptr, nullptr, a.out, XB, nullptr}; pg8::gemm_phase(lds, FF, FF, FF, S, E);
    }
#undef IN
#undef SEAM
}

extern "C" void kernel_launch(void* const* d_in, const int* in_sizes, int n_in, void* d_out, int out_size, void* d_ws, size_t ws_size, hipStream_t stream) {
    static int grid = 0;
    if (grid == 0) {
        if (n_in != 20 || out_size != T * D || ws_size < WS_END) { fprintf(stderr, "kernel_launch: unexpected shapes (n_in %d, out %d, ws %zu < %zu)\n", n_in, out_size, ws_size, (size_t)WS_END); grid = -1; return; }
        int dev = 0, cus = 0, per_cu = 0;
        (void)hipGetDevice(&dev); (void)hipDeviceGetAttribute(&cus, hipDeviceAttributeMultiprocessorCount, dev);
        if (hipFuncSetAttribute((const void*)mk_fwd, hipFuncAttributeMaxDynamicSharedMemorySize, LDS_BYTES) != hipSuccess) { fprintf(stderr, "kernel_launch: hipFuncSetAttribute failed\n"); grid = -1; return; }
        if (hipOccupancyMaxActiveBlocksPerMultiprocessor(&per_cu, (const void*)mk_fwd, NTHREADS, LDS_BYTES) != hipSuccess || per_cu < 1) { fprintf(stderr, "kernel_launch: occupancy query gave %d\n", per_cu); per_cu = 1; }
        (void)hipGetLastError();
        grid = cus;
    }
    if (grid < 0) return;
    Args a{};
    for (int i = 0; i < 20; ++i) a.in[i] = (const float*)d_in[i];
    a.out = (float*)d_out; a.ws = (unsigned char*)d_ws;
#if MK_MULTI_LAUNCH
    for (int ph = 0; ph < NPH; ++ph) { a.ph_lo = ph; a.ph_hi = ph + 1; hipLaunchKernelGGL(mk_fwd, dim3(grid), dim3(NTHREADS), LDS_BYTES, stream, a); }
#else
    a.ph_lo = 0; a.ph_hi = NPH;
    if (hipMemsetAsync((char*)d_ws + WS_BAR, 0, 16384, stream) != hipSuccess) { fprintf(stderr, "kernel_launch: memset of the barrier words failed\n"); return; }
    void* args[] = {&a};
    hipError_t e = hipLaunchCooperativeKernel((const void*)mk_fwd, dim3(grid), dim3(NTHREADS), args, LDS_BYTES, stream);
    if (e != hipSuccess) fprintf(stderr, "cooperative launch failed: %s (grid %d)\n", hipGetErrorString(e), grid);
#endif
}
```
